# Optimizing an MI355X kernel written in HIP

```python
import jax, jax.numpy as jnp
from jax import lax
import numpy as np

D_MODEL = 1024
BATCH = 2
SEQ = 8192
DEPTH = 4

D_MIX = D_MODEL
A_WIDTH = D_MIX // 2
B_WIDTH = D_MIX - A_WIDTH
A_HEADS = 4
A_HEAD_DIM = A_WIDTH // A_HEADS
CHUNK = 128
B_HEADS = 4
B_VAL_DIM = B_WIDTH // B_HEADS
B_KEY_DIM = B_VAL_DIM // 2
QK_WIDTH = B_HEADS * B_KEY_DIM
GATE_RANK = 16
GATE_NORMALIZER = 16.0
N_IN = 2 * A_WIDTH + 2 * QK_WIDTH + 2 * B_WIDTH + 2 * GATE_RANK
D_FF = 2816
CONV_WIDTH = 3
EPS = 1e-6

kernel_name = "hybrid_gmlp_gla_convffn_encoder"


def _split_points():
    sizes = [A_WIDTH, A_WIDTH, QK_WIDTH, QK_WIDTH, B_WIDTH, B_WIDTH, GATE_RANK, GATE_RANK]
    pts, acc = [], 0
    for s in sizes[:-1]:
        acc += s
        pts.append(acc)
    return pts


def _rmsnorm(x, g):
    xf = x.astype(jnp.float32)
    y = xf * lax.rsqrt(jnp.mean(xf * xf, axis=-1, keepdims=True) + EPS)
    return (y * g.astype(jnp.float32)).astype(x.dtype)


def _layernorm(x, g, b):
    xf = x.astype(jnp.float32)
    mu = jnp.mean(xf, axis=-1, keepdims=True)
    var = jnp.mean(jnp.square(xf - mu), axis=-1, keepdims=True)
    y = (xf - mu) * lax.rsqrt(var + EPS)
    return (y * g.astype(jnp.float32) + b.astype(jnp.float32)).astype(x.dtype)


def _spatial_gating(u, v, w_s, b_s, ln_g, ln_b):
    bsz, s = u.shape[0], u.shape[1]
    n = s // CHUNK
    vn = _layernorm(v, ln_g, ln_b).reshape(bsz, n, CHUNK, A_HEADS, A_HEAD_DIM)
    mixed = jnp.einsum('hij,bnjhd->bnihd', w_s, vn) + b_s.T[None, None, :, :, None]
    return u * mixed.reshape(bsz, s, A_HEADS, A_HEAD_DIM)


def _gla_chunked(q, k, v, log_a, include_diag):
    bsz, s, h, dk = q.shape
    dv = v.shape[-1]
    n = s // CHUNK
    f32 = jnp.float32
    qc = q.astype(f32).reshape(bsz, n, CHUNK, h, dk)
    kc = k.astype(f32).reshape(bsz, n, CHUNK, h, dk)
    vc = v.astype(f32).reshape(bsz, n, CHUNK, h, dv)
    cum = jnp.cumsum(log_a.astype(f32).reshape(bsz, n, CHUNK, h, dk), axis=2)
    cum_last = cum[:, :, -1:]
    q_dec = qc * jnp.exp(cum)
    k_inv = kc * jnp.exp(-cum)
    k_to_end = kc * jnp.exp(cum_last - cum)
    scores = jnp.einsum('bnihd,bnjhd->bnhij', q_dec, k_inv)
    mask = jnp.tril(jnp.ones((CHUNK, CHUNK), dtype=bool), k=0 if include_diag else -1)
    scores = jnp.where(mask, scores, 0.0)
    o_intra = jnp.einsum('bnhij,bnjhe->bnihe', scores, vc)
    d_state = jnp.einsum('bnjhd,bnjhe->bnhde', k_to_end, vc)
    chunk_decay = jnp.exp(cum_last[:, :, 0])

    def step(state, inp):
        ds, dec = inp
        return state * dec[..., None] + ds, state

    s0 = jnp.zeros((bsz, h, dk, dv), f32)
    _, states = lax.scan(step, s0, (jnp.swapaxes(d_state, 0, 1), jnp.swapaxes(chunk_decay, 0, 1)))
    states = jnp.swapaxes(states, 0, 1)
    o_inter = jnp.einsum('bnihd,bnhde->bnihe', q_dec, states)
    return (o_intra + o_inter).reshape(bsz, s, h, dv)


def _dwconv_centred(z, w, b):
    s = z.shape[1]
    half = CONV_WIDTH // 2
    zp = jnp.pad(z, ((0, 0), (half, half), (0, 0)))
    out = b
    for t in range(CONV_WIDTH):
        out = out + zp[:, t:t + s] * w[t]
    return out


def setup_inputs(seed: int = 0) -> dict:
    key = jax.random.key(seed)
    ks = jax.random.split(key, 20)
    f32 = jnp.float32
    nrm = lambda k, shape, scale: jax.random.normal(k, shape, f32) * scale
    return {
        "x": nrm(ks[0], (BATCH, SEQ, D_MODEL), 1.0),
        "g_mix": 1.0 + nrm(ks[1], (DEPTH, D_MODEL), 0.02),
        "w_in": nrm(ks[2], (DEPTH, D_MODEL, N_IN), D_MODEL ** -0.5),
        "w_s": nrm(ks[3], (DEPTH, A_HEADS, CHUNK, CHUNK), CHUNK ** -0.5),
        "b_s": 1.0 + nrm(ks[4], (DEPTH, A_HEADS, CHUNK), 0.1),
        "ln_g": 1.0 + nrm(ks[5], (DEPTH, A_HEADS, A_HEAD_DIM), 0.02),
        "ln_b": nrm(ks[6], (DEPTH, A_HEADS, A_HEAD_DIM), 0.02),
        "w_gate_f": nrm(ks[7], (DEPTH, GATE_RANK, QK_WIDTH), GATE_RANK ** -0.5),
        "b_gate_f": nrm(ks[8], (DEPTH, QK_WIDTH), 0.1),
        "w_gate_b": nrm(ks[9], (DEPTH, GATE_RANK, QK_WIDTH), GATE_RANK ** -0.5),
        "b_gate_b": nrm(ks[10], (DEPTH, QK_WIDTH), 0.1),
        "g_gla": 1.0 + nrm(ks[11], (DEPTH, B_HEADS, B_VAL_DIM), 0.02),
        "w_out": nrm(ks[12], (DEPTH, D_MIX, D_MODEL), D_MIX ** -0.5),
        "g_ffn": 1.0 + nrm(ks[13], (DEPTH, D_MODEL), 0.02),
        "w_up": nrm(ks[14], (DEPTH, D_MODEL, 2 * D_FF), D_MODEL ** -0.5),
        "conv_w": nrm(ks[15], (DEPTH, CONV_WIDTH, 2 * D_FF), CONV_WIDTH ** -0.5),
        "conv_b": nrm(ks[16], (DEPTH, 2 * D_FF), 0.02),
        "w_down": nrm(ks[17], (DEPTH, D_FF, D_MODEL), D_FF ** -0.5),
        "g_final": 1.0 + nrm(ks[18], (D_MODEL,), 0.02),
    }


def reference(x, g_mix, w_in, w_s, b_s, ln_g, ln_b, w_gate_f, b_gate_f, w_gate_b, b_gate_b,
              g_gla, w_out, g_ffn, w_up, conv_w, conv_b, w_down, g_final):
    bsz, s, _ = x.shape
    pts = _split_points()
    q_scale = B_KEY_DIM ** -0.5
    for l in range(DEPTH):
        h = _rmsnorm(x, g_mix[l])
        p = h @ w_in[l]
        pa_u, pa_v, pq, pk, pv, pg, r_f, r_b = jnp.split(p, pts, axis=-1)
        u = jax.nn.gelu(pa_u, approximate=False).reshape(bsz, s, A_HEADS, A_HEAD_DIM)
        va = jax.nn.gelu(pa_v, approximate=False).reshape(bsz, s, A_HEADS, A_HEAD_DIM)
        out_a = _spatial_gating(u, va, w_s[l], b_s[l], ln_g[l], ln_b[l])
        q = pq.reshape(bsz, s, B_HEADS, B_KEY_DIM) * q_scale
        k = pk.reshape(bsz, s, B_HEADS, B_KEY_DIM)
        vb = pv.reshape(bsz, s, B_HEADS, B_VAL_DIM)
        la_f = (jax.nn.log_sigmoid((r_f @ w_gate_f[l] + b_gate_f[l]).astype(jnp.float32))
                / GATE_NORMALIZER).reshape(bsz, s, B_HEADS, B_KEY_DIM)
        la_b = (jax.nn.log_sigmoid((r_b @ w_gate_b[l] + b_gate_b[l]).astype(jnp.float32))
                / GATE_NORMALIZER).reshape(bsz, s, B_HEADS, B_KEY_DIM)
        o_fwd = _gla_chunked(q, k, vb, la_f, True)
        o_bwd = jnp.flip(_gla_chunked(jnp.flip(q, 1), jnp.flip(k, 1), jnp.flip(vb, 1),
                                      jnp.flip(la_b, 1), False), 1)
        o = (o_fwd + o_bwd).astype(x.dtype)
        out_b = _rmsnorm(o, g_gla[l]) * jax.nn.silu(pg.reshape(bsz, s, B_HEADS, B_VAL_DIM))
        mixed = jnp.concatenate([out_a.reshape(bsz, s, A_WIDTH),
                                 out_b.reshape(bsz, s, B_WIDTH)], axis=-1)
        x = x + mixed @ w_out[l]
        h = _rmsnorm(x, g_ffn[l])
        z = _dwconv_centred(h @ w_up[l], conv_w[l], conv_b[l])
        z_gate, z_val = jnp.split(z, [D_FF], axis=-1)
        x = x + (jax.nn.silu(z_gate) * z_val) @ w_down[l]
    return _rmsnorm(x, g_final)
```

```cpp
#include <hip/hip_runtime.h>
#include <hip/hip_cooperative_groups.h>
#include <cstdio>
#include <cstdint>
namespace pg8 {
#define PG8_LAS __attribute__((address_space(3)))
typedef unsigned short bf16_t;
typedef short bf16x8 __attribute__((ext_vector_type(8)));
typedef float f32x4 __attribute__((ext_vector_type(4)));
typedef unsigned u32x4 __attribute__((ext_vector_type(4)));
constexpr int BM = 256, BK = 64, HALF = 128, HTB = HALF * BK * 2  , STAGE_BYTES = 8 * HTB, NXCD = 8, WGM = 8;

__host__ __device__ __forceinline__ int lds_byte(int r, int c) { const int st = (r >> 4) * 2 + (c >> 5), rr = r & 15, cc = c & 31, ob = rr * 64 + cc * 2; return st * 1024 + (ob ^ (((ob >> 9) & 1) << 5)); }
__host__ __device__ __forceinline__ void stage_rc(int b, int& R, int& C) { const int st = b / 1024, sb = b % 1024, swz = sb ^ (((sb >> 9) & 1) << 5); R = (st >> 1) * 16 + swz / 64; C = (st & 1) * 32 + (swz % 64) / 2; }
__host__ __device__ __forceinline__ int perm32(int rho) { const int n = rho >> 4, i = rho & 15; return 8 * (i >> 2) + 4 * n + (i & 3); }

struct Unit { int pm, pn; };
struct Gemm { const bf16_t* A; const bf16_t* Bt; int M, N, K; };

struct StaticOrder {
    int nM, nN, nwg, G, c;
    __host__ __device__ void init(int M, int N, int G_, int c_) { nM = M / BM; nN = N / BM; nwg = nM * nN; G = G_; c = c_; }
    __host__ __device__ bool next(int i, Unit& u) const {
        const long L = (long)i * G + c; if (L >= nwg) return false;
        int wgid = (int)L; { const int q = nwg / NXCD, r = nwg % NXCD, xcd = wgid % NXCD, off = wgid / NXCD; wgid = (xcd < r ? xcd * (q + 1) : r * (q + 1) + (xcd - r) * q) + off; }
        const int nig = WGM * nN, gid = wgid / nig, fm = gid * WGM, gsz = (nM - fm) < WGM ? (nM - fm) : WGM;
        u.pm = fm + ((wgid % nig) % gsz); u.pn = (wgid % nig) / gsz; return true;
    }
    __device__ __forceinline__ void a_ready(const Unit&) const {}
    __device__ __forceinline__ void done(const Unit&) const {}
};

__device__ __forceinline__ unsigned cvt_pk_bf16(float lo, float hi) { unsigned r; asm volatile("v_cvt_pk_bf16_f32 %0, %1, %2" : "=v"(r) : "v"(lo), "v"(hi)); return r; }
typedef float f32x2 __attribute__((ext_vector_type(2)));
__device__ __forceinline__ f32x2 gelu_pk(f32x2 v) {
    const f32x2 av = __builtin_elementwise_abs(v), d = av * 0.2316418882f + 1.0f;
    f32x2 t; t.x = __builtin_amdgcn_rcpf(d.x); t.y = __builtin_amdgcn_rcpf(d.y);
    f32x2 q = t * 0.5307027145f + (-0.7265760135f); q = q * t + 0.7107068705f; q = q * t + (-0.142248368f); q = q * t + 0.127414796f; q = q * t;
    const f32x2 s = (v * v) * (-0.72134752044f);
    f32x2 e; e.x = __builtin_amdgcn_exp2f(s.x); e.y = __builtin_amdgcn_exp2f(s.y);
    return __builtin_elementwise_max(v, (f32x2){0.f, 0.f}) - av * (q * e);
}

template <int ACT  > struct EpiBf16 {
    static constexpr bool PERM = true, AFTER_DRAIN = false; static_assert(ACT == 0 || ACT == 1, "EpiBf16: ACT is 0 (none) or 1 (gelu_pk)");
    bf16_t* O; int ldc; const float* bias; int split_cols; size_t split_stride; float scale0;
    __device__ __forceinline__ void operator()(const f32x4 (&acc)[2][2][4][2], const Unit& u, int wr, int wc, int fr, int fq) const {
        const int row0 = u.pm * BM + wr * 64 + fr; int colt = u.pn * BM; bf16_t* base = O;
        float sc = 1.f; if (split_cols) { const int t = colt / split_cols; base += (size_t)t * split_stride; colt -= t * split_cols; if (t == 0) sc = scale0; }
        const int col0 = colt + wc * 32 + 8 * fq, bcol0 = u.pn * BM + wc * 32 + 8 * fq;
        f32x4 bv[2][2];
#pragma unroll
        for (int bj = 0; bj < 2; ++bj)
#pragma unroll
            for (int n = 0; n < 2; ++n) bv[bj][n] = bias ? *(const f32x4*)(bias + bcol0 + bj * HALF + 4 * n) : (f32x4){0.f, 0.f, 0.f, 0.f};
#pragma unroll
        for (int ai = 0; ai < 2; ++ai)
#pragma unroll
            for (int m = 0; m < 4; ++m) { bf16_t* rowp = base + (size_t)(row0 + ai * HALF + m * 16) * ldc + col0;
#pragma unroll
                for (int bj = 0; bj < 2; ++bj) { f32x4 v0 = acc[ai][bj][m][0] + bv[bj][0], v1 = acc[ai][bj][m][1] + bv[bj][1];
                    if (ACT == 1) { f32x2 a = gelu_pk((f32x2){v0[0], v0[1]}), b = gelu_pk((f32x2){v0[2], v0[3]}), c = gelu_pk((f32x2){v1[0], v1[1]}), d = gelu_pk((f32x2){v1[2], v1[3]});
                        v0 = (f32x4){a.x, a.y, b.x, b.y}; v1 = (f32x4){c.x, c.y, d.x, d.y}; }
                    v0 = v0 * sc; v1 = v1 * sc; u32x4 w; w.x = cvt_pk_bf16(v0[0], v0[1]); w.y = cvt_pk_bf16(v0[2], v0[3]); w.z = cvt_pk_bf16(v1[0], v1[1]); w.w = cvt_pk_bf16(v1[2], v1[3]);
                    *(u32x4*)(rowp + bj * HALF) = w; } }
    }
};
template <class Epi, class Sched, bool ALIGN_EPI = false, bool SP2 = false>
__device__ __forceinline__ void gemm_phase(PG8_LAS unsigned char* lds, const Gemm g, const Sched& S, const Epi& E, const int tid) {
    const int wid = __builtin_amdgcn_readfirstlane(tid >> 6), lane = tid & 63, wr = wid >> 2, wc = wid & 3, fr = lane & 15, fq = lane >> 4;
    const int K = g.K, nt = K / BK;
    unsigned voffA[2], voffB[2];
#pragma unroll
    for (int i = 0; i < 2; ++i) { int R, C; stage_rc(tid * 16 + i * 8192, R, C); const int Rb = Epi::PERM ? ((R & ~31) + perm32(R & 31)) : R;
        const int Ra = Epi::APERM ? ((R & ~63) | ((R & 15) << 2) | ((R >> 4) & 3)) : R;
        voffA[i] = (unsigned)(Ra * K + C) * 2u; voffB[i] = (unsigned)(Rb * K + C) * 2u; }
    const size_t kstep = (size_t)(BK * 2);
    const size_t hstep = (size_t)HALF * K * 2;
    const size_t tstep = 2 * hstep;
    const unsigned ldsw = (unsigned)wid * 1024u;
    const int aoff = lds_byte(wr * 64 + fr, fq * 8), boff = lds_byte(wc * 32 + fr, fq * 8);
#define PG8_SA(b, h) (((b) * 2 + (h)) * HTB)
#define PG8_SB(b, h) ((4 + (b) * 2 + (h)) * HTB)
#define PG8_STAGE(bufoff, gbase, voff) do { _Pragma("unroll") for (int _i = 0; _i < 2; ++_i) \
        __builtin_amdgcn_global_load_lds((const unsigned*)((const char*)(gbase) + (voff)[_i]), (PG8_LAS unsigned*)(lds + (bufoff) + ldsw + _i * 8192), 16, 0, 0); } while (0)
#define PG8_LDA(dst, b, h) do { _Pragma("unroll") for (int m = 0; m < 4; ++m) _Pragma("unroll") for (int k = 0; k < 2; ++k) dst[m][k] = *(const PG8_LAS bf16x8*)(lds + PG8_SA(b, h) + aoff + m * 2048 + k * 1024); } while (0)
#define PG8_LDB(dst, b, h) do { _Pragma("unroll") for (int n = 0; n < 2; ++n) _Pragma("unroll") for (int k = 0; k < 2; ++k) dst[n][k] = *(const PG8_LAS bf16x8*)(lds + PG8_SB(b, h) + boff + n * 2048 + k * 1024); } while (0)
#define PG8_MMA(ai, bj, At, Bt) do { __builtin_amdgcn_s_setprio(1); _Pragma("unroll") for (int m = 0; m < 4; ++m) _Pragma("unroll") for (int n = 0; n < 2; ++n) _Pragma("unroll") for (int k = 0; k < 2; ++k) \
        acc[ai][bj][m][n] = __builtin_amdgcn_mfma_f32_16x16x32_bf16(Bt[n][k], At[m][k], acc[ai][bj][m][n], 0, 0, 0); __builtin_amdgcn_s_setprio(0); } while (0)
#define PG8_WAIT_V(n) asm volatile("s_waitcnt vmcnt(" #n ")" ::: "memory")
#define PG8_WAIT_L(n) asm volatile("s_waitcnt lgkmcnt(" #n ")" ::: "memory")
#define PG8_BAR __builtin_amdgcn_s_barrier()
#define PG8_SCHED __builtin_amdgcn_sched_barrier(0)
    Unit cur, nxt; int ui = 0;
    if (!S.next(0, cur)) return;
    f32x4 acc[2][2][4][2];
#pragma unroll
    for (int a = 0; a < 2; ++a)
#pragma unroll
        for (int b = 0; b < 2; ++b)
#pragma unroll
            for (int m = 0; m < 4; ++m)
#pragma unroll
                for (int n = 0; n < 2; ++n) acc[a][b][m][n] = (f32x4){0.f, 0.f, 0.f, 0.f};
    bf16x8 At[4][2], B0[2][2], B1[2][2];
    const char* cA = (const char*)g.A + (size_t)cur.pm * tstep; const char* cB = (const char*)g.Bt + (size_t)cur.pn * tstep;
    S.a_ready(cur);
    if constexpr (SP2) {
        PG8_STAGE(PG8_SB(0, 0), cB, voffB); PG8_STAGE(PG8_SB(0, 1), cB + hstep, voffB); PG8_STAGE(PG8_SA(0, 0), cA, voffA); PG8_STAGE(PG8_SA(0, 1), cA + hstep, voffA);
        if (wr == 1) PG8_BAR;
        PG8_WAIT_V(2); PG8_BAR;
        PG8_STAGE(PG8_SB(1, 0), cB + kstep, voffB); PG8_STAGE(PG8_SA(1, 0), cA + kstep, voffA); PG8_STAGE(PG8_SB(1, 1), cB + hstep + kstep, voffB);
        PG8_WAIT_V(6); PG8_BAR;
    } else {
        PG8_STAGE(PG8_SB(0, 0), cB, voffB); PG8_STAGE(PG8_SA(0, 0), cA, voffA); PG8_STAGE(PG8_SB(0, 1), cB + hstep, voffB); PG8_STAGE(PG8_SA(0, 1), cA + hstep, voffA);
        if (wr == 1) PG8_BAR;
        PG8_WAIT_V(4); PG8_BAR;
        PG8_STAGE(PG8_SB(1, 0), cB + kstep, voffB); PG8_STAGE(PG8_SA(1, 0), cA + kstep, voffA); PG8_STAGE(PG8_SB(1, 1), cB + hstep + kstep, voffB);
        PG8_WAIT_V(6); PG8_BAR;
    }
    for (;;) {
        const bool has_next = S.next(ui + 1, nxt);
        const char* nA = has_next ? (const char*)g.A + (size_t)nxt.pm * tstep : cA; const char* nB = has_next ? (const char*)g.Bt + (size_t)nxt.pn * tstep : cB;
        for (int t = 0; t < nt; t += 2) {
            const bool last = (t == nt - 2);
            const char* a1 = cA + (size_t)(t + 1) * kstep;
            const char* a2 = last ? nA : cA + (size_t)(t + 2) * kstep; const char* b2 = last ? nB : cB + (size_t)(t + 2) * kstep;
            const char* a3 = a2 + kstep; const char* b3 = b2 + kstep;
            if (last && has_next) S.a_ready(nxt);
            if constexpr (SP2) {
            PG8_LDB(B0, 0, 0); PG8_LDB(B1, 0, 1); PG8_SCHED; PG8_LDA(At, 0, 0); PG8_STAGE(PG8_SA(1, 1), a1 + hstep, voffA);
            PG8_WAIT_V(8); PG8_WAIT_L(0); PG8_BAR; PG8_MMA(0, 0, At, B0); PG8_MMA(0, 1, At, B1); PG8_BAR; PG8_SCHED;
            PG8_LDA(At, 0, 1); PG8_STAGE(PG8_SB(0, 0), b2, voffB); PG8_STAGE(PG8_SB(0, 1), b2 + hstep, voffB); PG8_STAGE(PG8_SA(0, 0), a2, voffA);
            PG8_WAIT_V(8); PG8_WAIT_L(0); PG8_BAR; PG8_MMA(1, 0, At, B0); PG8_MMA(1, 1, At, B1); PG8_BAR; PG8_SCHED;
            PG8_LDB(B0, 1, 0); PG8_LDB(B1, 1, 1); PG8_SCHED; PG8_LDA(At, 1, 0); PG8_STAGE(PG8_SA(0, 1), a2 + hstep, voffA);
            PG8_WAIT_V(8); PG8_WAIT_L(0); PG8_BAR; PG8_MMA(0, 0, At, B0); PG8_MMA(0, 1, At, B1); PG8_BAR; PG8_SCHED;
            PG8_LDA(At, 1, 1); PG8_STAGE(PG8_SB(1, 0), b3, voffB); PG8_STAGE(PG8_SB(1, 1), b3 + hstep, voffB); PG8_STAGE(PG8_SA(1, 0), a3, voffA);
            PG8_WAIT_V(8); PG8_WAIT_L(0); PG8_BAR; PG8_MMA(1, 0, At, B0); PG8_MMA(1, 1, At, B1); PG8_BAR; PG8_SCHED;
            } else {
            PG8_LDB(B0, 0, 0); PG8_SCHED; PG8_LDA(At, 0, 0); PG8_STAGE(PG8_SA(1, 1), a1 + hstep, voffA);
            PG8_WAIT_L(8); PG8_BAR; PG8_WAIT_L(0); PG8_MMA(0, 0, At, B0); PG8_BAR; PG8_SCHED;
            PG8_LDB(B1, 0, 1); PG8_STAGE(PG8_SB(0, 0), b2, voffB);
            PG8_BAR; PG8_WAIT_L(0); PG8_MMA(0, 1, At, B1); PG8_BAR;
            PG8_LDA(At, 0, 1); PG8_STAGE(PG8_SA(0, 0), a2, voffA);
            PG8_BAR; PG8_WAIT_L(0); PG8_MMA(1, 0, At, B0); PG8_BAR; PG8_SCHED;
            PG8_STAGE(PG8_SB(0, 1), b2 + hstep, voffB);
            PG8_WAIT_V(6); PG8_BAR; PG8_MMA(1, 1, At, B1); PG8_BAR;
            PG8_LDB(B0, 1, 0); PG8_SCHED; PG8_LDA(At, 1, 0); PG8_STAGE(PG8_SA(0, 1), a2 + hstep, voffA);
            PG8_WAIT_L(8); PG8_BAR; PG8_WAIT_L(0); PG8_MMA(0, 0, At, B0); PG8_BAR; PG8_SCHED;
            PG8_LDB(B1, 1, 1); PG8_STAGE(PG8_SB(1, 0), b3, voffB);
            PG8_BAR; PG8_WAIT_L(0); PG8_MMA(0, 1, At, B1); PG8_BAR;
            PG8_LDA(At, 1, 1); PG8_STAGE(PG8_SA(1, 0), a3, voffA);
            PG8_BAR; PG8_WAIT_L(0); PG8_MMA(1, 0, At, B0); PG8_BAR; PG8_SCHED;
            PG8_STAGE(PG8_SB(1, 1), b3 + hstep, voffB);
            PG8_WAIT_V(6); PG8_BAR; PG8_MMA(1, 1, At, B1); PG8_BAR;
            }
        }
        if constexpr (ALIGN_EPI) { if (wr == 0) PG8_BAR; }
        if constexpr (!Epi::AFTER_DRAIN) { E(acc, cur, wr, wc, fr, fq); S.done(cur); }
        if (!has_next) break;
#pragma unroll
        for (int a = 0; a < 2; ++a)
#pragma unroll
            for (int b = 0; b < 2; ++b)
#pragma unroll
                for (int m = 0; m < 4; ++m)
#pragma unroll
                    for (int n = 0; n < 2; ++n) acc[a][b][m][n] = (f32x4){0.f, 0.f, 0.f, 0.f};
        cur = nxt; cA = nA; cB = nB; ++ui;
        if constexpr (ALIGN_EPI) { if (wr == 1) PG8_BAR; }
    }
    PG8_WAIT_V(0);
    if constexpr (!ALIGN_EPI) { if (wr == 0) PG8_BAR; }
    PG8_BAR;
    if constexpr (Epi::AFTER_DRAIN) { E.fused(acc, cur, wr, wc, fr, fq, lds, wid, lane); S.done(cur); }
#undef PG8_SA
#undef PG8_SB
#undef PG8_STAGE
#undef PG8_LDA
#undef PG8_LDB
#undef PG8_MMA
#undef PG8_WAIT_V
#undef PG8_WAIT_L
#undef PG8_BAR
#undef PG8_SCHED
}
}
#define LAS __attribute__((address_space(3)))
#define XB_TMO      128
#define XB_XCNT(j)  (256  + 64 * (j))
#define XB_XSUB(j)  (1280 + 64 * (j))
#define XB_XGEN(j)  (2304 + 64 * (j))
#define XB_TOP      3328
#define XB_TOPGEN   3392
#define XCD_BAR_WORDS 3456
#define XB_SPIN_CAP (1u << 18)

__device__ __forceinline__ unsigned xb_ld(unsigned* p)              { return __hip_atomic_load(p, __ATOMIC_RELAXED, __HIP_MEMORY_SCOPE_AGENT); }
__device__ __forceinline__ unsigned xb_add(unsigned* p, unsigned v) { return __hip_atomic_fetch_add(p, v, __ATOMIC_RELAXED, __HIP_MEMORY_SCOPE_AGENT); }
__device__ __forceinline__ unsigned xb_xcc_id() { return (unsigned)__builtin_amdgcn_s_getreg((3 << 11) | 20) & 0xFu; }
#define XB_SPIN(cond, bar) do { unsigned _sp = 0; while (cond) { __builtin_amdgcn_s_sleep(1); \
    if ((++_sp & 255u) == 0u) { if (xb_ld(&(bar)[XB_TMO])) break; if (_sp > XB_SPIN_CAP) { atomicAdd(&(bar)[XB_TMO], 1u); break; } } } } while (0)

struct XcdBarrier {
    unsigned* bar; unsigned x;
    volatile LAS unsigned* st;
};

__device__ __forceinline__ XcdBarrier xcd_barrier_post(unsigned* bar, volatile LAS unsigned* st, const int tid) {
    XcdBarrier b; b.bar = bar; b.x = xb_xcc_id(); b.st = st;
    if (tid == 0) (void)xb_add(&bar[XB_XCNT(b.x)], 1u);
    return b;
}
__device__ __forceinline__ void xcd_barrier_complete(unsigned* bar, unsigned x, unsigned& nloc, unsigned& nx) {
    const unsigned G = gridDim.x * gridDim.y * gridDim.z;
    unsigned sum, cnt, mine, sp = 0u;
    for (;;) {
        sum = 0u; cnt = 0u; mine = 0u;
#pragma unroll
        for (unsigned j = 0; j < 16; ++j) { const unsigned c = xb_ld(&bar[XB_XCNT(j)]); sum += c; cnt += (c > 0u) ? 1u : 0u; mine = (j == x) ? c : mine; }
        if (sum == G) break;
        __builtin_amdgcn_s_sleep(1);
        if ((++sp & 255u) == 0u) { if (xb_ld(&bar[XB_TMO])) break; if (sp > XB_SPIN_CAP) { atomicAdd(&bar[XB_TMO], 1u); break; } }
    }
    nloc = mine > 0u ? mine : 1u; nx = cnt > 0u ? cnt : 1u;
}

__device__ __forceinline__ void xcd_barrier(const XcdBarrier& b, const int tid) {
    asm volatile("s_waitcnt vmcnt(0)" ::: "memory");
    __syncthreads();
    if (tid == 0) {
        unsigned* bar = b.bar;
        __builtin_amdgcn_s_waitcnt(0);
        unsigned nloc = b.st[0], nx = b.st[1];
        if (nloc == 0u) { xcd_barrier_complete(bar, b.x, nloc, nx); b.st[0] = nloc; b.st[1] = nx; }
        const unsigned old = xb_add(&bar[XB_XSUB(b.x)], 1u);
        const unsigned gen = old / nloc;
        if (old + 1u == (gen + 1u) * nloc) {
            __builtin_amdgcn_fence(__ATOMIC_RELEASE, "agent");
            asm volatile("s_waitcnt vmcnt(0)" ::: "memory");
            const unsigned og = xb_add(&bar[XB_TOP], 1u);
            const unsigned tg = og / nx;
            if (og + 1u == (tg + 1u) * nx) xb_add(&bar[XB_TOPGEN], 1u);
            else XB_SPIN(xb_ld(&bar[XB_TOPGEN]) == tg, bar);
            __builtin_amdgcn_fence(__ATOMIC_ACQUIRE, "agent");
            xb_add(&bar[XB_XGEN(b.x)], 1u);
            asm volatile("s_waitcnt vmcnt(0)" ::: "memory");
        } else {
            XB_SPIN(xb_ld(&bar[XB_XGEN(b.x)]) == gen, bar);
            __builtin_amdgcn_fence(__ATOMIC_ACQUIRE, "agent");
            asm volatile("s_waitcnt vmcnt(0)" ::: "memory");
        }
    }
    __syncthreads();
}
#ifndef PG8_SP2
#define PG8_SP2 true
#endif
#ifndef PG8_ALIGN
#define PG8_ALIGN true
#endif
#ifndef NLAYERS
#define NLAYERS 4
#endif
#ifndef MK_SINGLE
#define MK_SINGLE 1
#endif
namespace cg = cooperative_groups;
#define LAS __attribute__((address_space(3)))
typedef unsigned short bf16;
typedef float f32x4 __attribute__((ext_vector_type(4)));
typedef float f32x2 __attribute__((ext_vector_type(2)));
typedef short bf16x8 __attribute__((ext_vector_type(8)));
typedef unsigned u32x4 __attribute__((ext_vector_type(4)));
typedef unsigned u32x2 __attribute__((ext_vector_type(2)));

__device__ __forceinline__ void xcd_arrive(const XcdBarrier& b, const int tid) {
    asm volatile("s_waitcnt vmcnt(0)" ::: "memory");
    __syncthreads();
    if (tid == 0) {
        unsigned* bar = b.bar;
        __builtin_amdgcn_s_waitcnt(0);
        unsigned nloc = b.st[0], nx = b.st[1];
        if (nloc == 0u) { xcd_barrier_complete(bar, b.x, nloc, nx); b.st[0] = nloc; b.st[1] = nx; }
        const unsigned old = xb_add(&bar[XB_XSUB(b.x)], 1u);
        const unsigned gen = old / nloc;
        b.st[2] = gen;
        if (old + 1u == (gen + 1u) * nloc) {
            __builtin_amdgcn_fence(__ATOMIC_RELEASE, "agent");
            asm volatile("s_waitcnt vmcnt(0)" ::: "memory");
            (void)xb_add(&bar[XB_XGEN(b.x)], 1u);
            asm volatile("s_waitcnt vmcnt(0)" ::: "memory");
            const unsigned og = xb_add(&bar[XB_TOP], 1u);
            const unsigned tg = og / nx;
            if (og + 1u == (tg + 1u) * nx) xb_add(&bar[XB_TOPGEN], 1u);
        }
    }
    __syncthreads();
}
__device__ __forceinline__ void xcd_wait(const XcdBarrier& b, const int tid) {
    __syncthreads();
    if (tid == 0) {
        unsigned* bar = b.bar;
        const unsigned gen = b.st[2];
        XB_SPIN(xb_ld(&bar[XB_TOPGEN]) <= gen, bar);
        __builtin_amdgcn_fence(__ATOMIC_ACQUIRE, "agent");
        asm volatile("s_waitcnt vmcnt(0)" ::: "memory");
    }
    __syncthreads();
}
constexpr int NTHR = 512;
constexpr int BATCH = 2, SEQ = 8192, D = 1024, M = BATCH * SEQ, DEPTH = 4;
constexpr int NIN = 2592, NINP = 2816, FF = 2816, NUP = 5632;
constexpr float EPS = 1e-6f;
constexpr int NPHASE = 1 + 8 * DEPTH;
constexpr size_t MiB = 1u << 20;
constexpr size_t WS_WIN = 2 * MiB, WS_WOUT = 8 * MiB, WS_WUP = 10 * MiB, WS_WDOWN = 21 * MiB;
constexpr size_t WS_R1 = 28 * MiB;
constexpr size_t WS_P = WS_R1, WS_MIX = WS_R1 + 88 * MiB, WS_DS = WS_R1 + 120 * MiB, WS_ST = WS_R1 + 152 * MiB, WS_DEC = WS_R1 + 168 * MiB;
constexpr size_t WS_R2 = 204 * MiB;
constexpr size_t WS_CUM = WS_R2;
constexpr size_t WS_XB = 292 * MiB;
constexpr size_t WS_END = 324 * MiB;
constexpr size_t WS_SSM = 1024 * 1024, WS_SSF = WS_SSM + 256 * 1024;
constexpr size_t WS_XN2 = WS_MIX;
constexpr int LDS_BYTES = 131072 + 16384 + 64, MISC_OFF = LDS_BYTES - 64, XL_OFF = 131072;
constexpr int CW_PCNT = 8192;
constexpr int CW_BAR = 4096;
constexpr size_t CTL_ZERO_BYTES = 65536;
constexpr int LDT = 136, LDK = 72;
constexpr int MB0 = 0, MB1 = 34816, MB2 = 69632, MB3 = 104448;
constexpr int RBUF_OFF = MB1, TOT_OFF = MB1 + 16384;

struct Args { const float* in[19]; float* out; unsigned char* ws; int ph_lo, ph_hi; };

__device__ __forceinline__ unsigned pk2(float lo, float hi) { return pg8::cvt_pk_bf16(lo, hi); }
__device__ __forceinline__ float bf_lo(unsigned u) { return __uint_as_float(u << 16); }
__device__ __forceinline__ float bf_hi(unsigned u) { return __uint_as_float(u & 0xffff0000u); }
__device__ __forceinline__ unsigned f2bf(float f) { unsigned u = __float_as_uint(f); return (u + 0x7fffu + ((u >> 16) & 1u)) >> 16; }
__device__ __forceinline__ float wave_sum(float v) {
#pragma unroll
    for (int o = 1; o < 64; o <<= 1) v += __shfl_xor(v, o);
    return v;
}
template <int CTRL, int ROWMASK, bool BC> __device__ __forceinline__ float dpp_add(float v) { return v + __int_as_float(__builtin_amdgcn_update_dpp(0, __float_as_int(v), CTRL, ROWMASK, 0xf, BC)); }
__device__ __forceinline__ float wave_sum_dpp(float v) {
    v = dpp_add<0x111, 0xf, true>(v); v = dpp_add<0x112, 0xf, true>(v); v = dpp_add<0x114, 0xf, true>(v); v = dpp_add<0x118, 0xf, true>(v);
    v = dpp_add<0x142, 0xa, false>(v); v = dpp_add<0x143, 0xc, false>(v);
    return __int_as_float(__builtin_amdgcn_readlane(__float_as_int(v), 63));
}
__device__ __forceinline__ float silu_f(float x) { return x * __frcp_rn(1.f + __expf(-x)); }
__device__ __forceinline__ f32x4 silu4(f32x4 x) {
    const f32x4 a = x * (-1.44269504089f);
    f32x4 e; e[0] = __builtin_amdgcn_exp2f(a[0]); e[1] = __builtin_amdgcn_exp2f(a[1]); e[2] = __builtin_amdgcn_exp2f(a[2]); e[3] = __builtin_amdgcn_exp2f(a[3]);
    const f32x4 d = e + 1.f;
    f32x4 r; r[0] = __builtin_amdgcn_rcpf(d[0]); r[1] = __builtin_amdgcn_rcpf(d[1]); r[2] = __builtin_amdgcn_rcpf(d[2]); r[3] = __builtin_amdgcn_rcpf(d[3]);
    return x * r;
}
__device__ __forceinline__ float logsig_f(float x) { return fminf(x, 0.f) - __logf(1.f + __expf(-fabsf(x))); }

__device__ __forceinline__ float lds_rstd(const LAS unsigned char* slot, int rowlocal) { const f32x4 p = *(const LAS f32x4*)(slot + 4096 + rowlocal * 16); return rsqrtf(((p[0] + p[1]) + (p[2] + p[3])) * (1.f / D) + EPS); }
__device__ __forceinline__ float row_rstd(const float* ssp, int row) { const f32x4 p = *(const f32x4*)(ssp + (size_t)row * 4); return rsqrtf(((p[0] + p[1]) + (p[2] + p[3])) * (1.f / D) + EPS); }
struct EpiIn {
    static constexpr bool PERM = true, AFTER_DRAIN = false, APERM = false;
    bf16* O; LAS unsigned char* xl; mutable int cnt;
    __device__ __forceinline__ void operator()(const f32x4 (&acc)[2][2][4][2], const pg8::Unit& u, int wr, int wc, int fr, int fq) const {
        const int row0 = u.pm * 256 + wr * 64 + fr, col0 = u.pn * 256 + wc * 32 + 8 * fq;
        const LAS unsigned char* slot = xl + (cnt & 1) * 8192; ++cnt;
        if (u.pn * 256 + wc * 32 >= NIN) return;
        const bool act = u.pn < 4; const float sc = (u.pn == 4) ? 0.125f : 1.f;
        float rsa[2][4];
#pragma unroll
        for (int ai = 0; ai < 2; ++ai)
#pragma unroll
            for (int m = 0; m < 4; ++m) rsa[ai][m] = lds_rstd(slot, ai * 128 + wr * 64 + m * 16 + fr);
#pragma unroll
        for (int ai = 0; ai < 2; ++ai)
#pragma unroll
            for (int m = 0; m < 4; ++m) { const int row = row0 + ai * 128 + m * 16; bf16* rowp = O + (size_t)row * NINP + col0;
                const float rs = rsa[ai][m];
#pragma unroll
                for (int bj = 0; bj < 2; ++bj) { f32x4 v0 = acc[ai][bj][m][0] * rs, v1 = acc[ai][bj][m][1] * rs;
                    if (act) { f32x2 a = pg8::gelu_pk((f32x2){v0[0], v0[1]}), b = pg8::gelu_pk((f32x2){v0[2], v0[3]}), c = pg8::gelu_pk((f32x2){v1[0], v1[1]}), d = pg8::gelu_pk((f32x2){v1[2], v1[3]});
                        v0 = (f32x4){a.x, a.y, b.x, b.y}; v1 = (f32x4){c.x, c.y, d.x, d.y}; }
                    v0 = v0 * sc; v1 = v1 * sc; u32x4 w; w.x = pk2(v0[0], v0[1]); w.y = pk2(v0[2], v0[3]); w.z = pk2(v1[0], v1[1]); w.w = pk2(v1[2], v1[3]);
                    *(u32x4*)(rowp + bj * 128) = w; } }
    }
};
struct EpiUp {
    static constexpr bool PERM = true, AFTER_DRAIN = false;
    bf16* O; const float* ss;
    __device__ __forceinline__ void operator()(const f32x4 (&acc)[2][2][4][2], const pg8::Unit& u, int wr, int wc, int fr, int fq) const {
        const int row0 = u.pm * 256 + wr * 64 + fr, col0 = u.pn * 256 + wc * 32 + 8 * fq;
#pragma unroll
        for (int ai = 0; ai < 2; ++ai)
#pragma unroll
            for (int m = 0; m < 4; ++m) { const int row = row0 + ai * 128 + m * 16; bf16* rowp = O + (size_t)row * NUP + col0;
                const float rs = row_rstd(ss, row);
#pragma unroll
                for (int bj = 0; bj < 2; ++bj) { const f32x4 v0 = acc[ai][bj][m][0] * rs, v1 = acc[ai][bj][m][1] * rs;
                    u32x4 w; w.x = pk2(v0[0], v0[1]); w.y = pk2(v0[2], v0[3]); w.z = pk2(v1[0], v1[1]); w.w = pk2(v1[2], v1[3]);
                    *(u32x4*)(rowp + bj * 128) = w; } }
    }
};
template <bool LAST>
struct EpiRes16 {
    static constexpr bool PERM = true, AFTER_DRAIN = true, APERM = false;
    bf16* xb; float* out; float* ssp; const float* gfin; unsigned* pcnt;
    __device__ __forceinline__ void fused(f32x4 (&acc)[2][2][4][2], const pg8::Unit& u, int wr, int wc, int fr, int fq, PG8_LAS unsigned char* lds, int wid, int lane) const {
        const int row0 = u.pm * 256 + wr * 64 + fr, col0 = u.pn * 256 + wc * 32 + 8 * fq;
        PG8_LAS float* part = (PG8_LAS float*)lds;
        PG8_LAS float* rtab = (PG8_LAS float*)(lds + 4096);
        u32x4 xva[2][4][2];
#pragma unroll
        for (int ai = 0; ai < 2; ++ai)
#pragma unroll
            for (int m = 0; m < 4; ++m)
#pragma unroll
                for (int bj = 0; bj < 2; ++bj) xva[ai][m][bj] = *(const u32x4*)(xb + (size_t)(row0 + ai * 128 + m * 16) * D + col0 + bj * 128);
        f32x4 gq[2][2];
        if (LAST) {
#pragma unroll
            for (int bj = 0; bj < 2; ++bj) { gq[bj][0] = *(const f32x4*)(gfin + col0 + bj * 128); gq[bj][1] = *(const f32x4*)(gfin + col0 + bj * 128 + 4); } }
#pragma unroll
        for (int ai = 0; ai < 2; ++ai)
#pragma unroll
            for (int m = 0; m < 4; ++m) { const int row = row0 + ai * 128 + m * 16; const size_t off = (size_t)row * D + col0; float sq = 0.f;
#pragma unroll
                for (int bj = 0; bj < 2; ++bj) { const u32x4 xv = xva[ai][m][bj];
                    const f32x4 x0 = (f32x4){bf_lo(xv.x), bf_hi(xv.x), bf_lo(xv.y), bf_hi(xv.y)} + acc[ai][bj][m][0], x1 = (f32x4){bf_lo(xv.z), bf_hi(xv.z), bf_lo(xv.w), bf_hi(xv.w)} + acc[ai][bj][m][1];
                    { const f32x4 s4 = x0 * x0 + x1 * x1; sq += (s4[0] + s4[1]) + (s4[2] + s4[3]); }
                    if (LAST) { acc[ai][bj][m][0] = x0; acc[ai][bj][m][1] = x1; }
                    else *(u32x4*)(xb + off + bj * 128) = (u32x4){pk2(x0[0], x0[1]), pk2(x0[2], x0[3]), pk2(x1[0], x1[1]), pk2(x1[2], x1[3])}; }
                sq += __shfl_xor(sq, 16); sq += __shfl_xor(sq, 32);
                if (fq == 0) part[(ai * 128 + wr * 64 + m * 16 + fr) * 4 + wc] = sq; }
        asm volatile("s_waitcnt lgkmcnt(0)" ::: "memory"); __builtin_amdgcn_s_barrier(); asm volatile("" ::: "memory");
        const int t = wid * 64 + lane;
        float own = 0.f;
        if (t < 256) { const f32x4 p = *(const PG8_LAS f32x4*)(part + t * 4); own = (p[0] + p[1]) + (p[2] + p[3]); }
        if (!LAST) { if (t < 256) ssp[(size_t)(u.pm * 256 + t) * 4 + u.pn] = own; }
        else {
            if (t < 256) __hip_atomic_store(ssp + (size_t)(u.pm * 256 + t) * 4 + u.pn, own, __ATOMIC_RELAXED, __HIP_MEMORY_SCOPE_AGENT);
            asm volatile("s_waitcnt vmcnt(0)" ::: "memory");
            if (wid < 4 && lane == 0) __hip_atomic_fetch_add(pcnt + 64 * u.pm, 1u, __ATOMIC_RELAXED, __HIP_MEMORY_SCOPE_AGENT);
            if (wid == 0) {
                for (unsigned sp = 0; sp < (1u << 20); ++sp) {
                    if ((unsigned)__builtin_amdgcn_readfirstlane((int)__hip_atomic_load(pcnt + 64 * u.pm, __ATOMIC_RELAXED, __HIP_MEMORY_SCOPE_AGENT)) >= 16u) break;
                    __builtin_amdgcn_s_sleep(2);
                }
                __builtin_amdgcn_fence(__ATOMIC_ACQUIRE, "agent");
            }
            asm volatile("s_waitcnt vmcnt(0) lgkmcnt(0)" ::: "memory"); __builtin_amdgcn_s_barrier(); asm volatile("" ::: "memory");
            if (t < 256) { const float* sp4 = ssp + (size_t)(u.pm * 256 + t) * 4; float q4[4];
#pragma unroll
                for (int k = 0; k < 4; ++k) q4[k] = __hip_atomic_load(sp4 + k, __ATOMIC_RELAXED, __HIP_MEMORY_SCOPE_AGENT);
                rtab[t] = rsqrtf(((q4[0] + q4[1]) + (q4[2] + q4[3])) * (1.f / D) + EPS); }
            asm volatile("s_waitcnt vmcnt(0) lgkmcnt(0)" ::: "memory"); __builtin_amdgcn_s_barrier(); asm volatile("" ::: "memory");
#pragma unroll
            for (int ai = 0; ai < 2; ++ai)
#pragma unroll
                for (int m = 0; m < 4; ++m) { const float rs = rtab[ai * 128 + wr * 64 + m * 16 + fr]; const size_t off = (size_t)(row0 + ai * 128 + m * 16) * D + col0;
#pragma unroll
                    for (int bj = 0; bj < 2; ++bj) { *(f32x4*)(out + off + bj * 128) = acc[ai][bj][m][0] * rs * gq[bj][0]; *(f32x4*)(out + off + bj * 128 + 4) = acc[ai][bj][m][1] * rs * gq[bj][1]; } }
        }
    }
};

struct PrefetchOrder : pg8::StaticOrder {
    const float* ssp; const float* cw; const float* cb; LAS unsigned char* xl; int tid; mutable int cnt;
    __device__ __forceinline__ void a_ready(const pg8::Unit& u) const {
        LAS unsigned char* dst = xl + (cnt & 1) * 8192; ++cnt;
        const int wv = __builtin_amdgcn_readfirstlane(tid >> 6), ln = tid & 63;
        if (wv < 4) {
            if (cw) { const int run = 2 * wv + (ln >> 5), k = run & 3, half = run >> 2;
                const float* src = (k < 3 ? cw + (size_t)k * NUP : cb) + half * FF + u.pn * 128 + (ln & 31) * 4;
                __builtin_amdgcn_global_load_lds((const unsigned*)src, (LAS unsigned*)(dst + wv * 1024), 16, 0, 0); }
        } else {
            const float* src = ssp + (size_t)(u.pm * 256 + (wv - 4) * 64 + ln) * 4;
            __builtin_amdgcn_global_load_lds((const unsigned*)src, (LAS unsigned*)(dst + 4096 + (wv - 4) * 1024), 16, 0, 0);
        }
    }
};
constexpr int DPP_SHR1 = 0x111, DPP_SHL1 = 0x101, DPP_ROR1 = 0x121, DPP_ROR15 = 0x12F;
template <int CTRL> __device__ __forceinline__ float dpp0(float v) { return __int_as_float(__builtin_amdgcn_update_dpp(0, __float_as_int(v), CTRL, 0xf, 0xf, true)); }
__device__ __forceinline__ float dpp_prev(float cur, float grp_below) {
    const int t = __builtin_amdgcn_update_dpp(0, __float_as_int(grp_below), DPP_ROR1, 0xf, 0xf, false);
    return __int_as_float(__builtin_amdgcn_update_dpp(t, __float_as_int(cur), DPP_SHR1, 0xf, 0xf, false)); }
__device__ __forceinline__ float dpp_next(float cur, float grp_above) {
    const int t = __builtin_amdgcn_update_dpp(0, __float_as_int(grp_above), DPP_ROR15, 0xf, 0xf, false);
    return __int_as_float(__builtin_amdgcn_update_dpp(t, __float_as_int(cur), DPP_SHL1, 0xf, 0xf, false)); }
struct EpiUpConv {
    static constexpr bool PERM = false, AFTER_DRAIN = false, APERM = true;
    bf16* ACT; bf16* YB; LAS unsigned char* xl; mutable int cnt;
    __device__ __forceinline__ void operator()(const f32x4 (&acc)[2][2][4][2], const pg8::Unit& u, int wr, int wc, int fr, int fq) const {
        const int cg0 = wc * 32 + 4 * fq, jg0 = u.pn * 128 + cg0;
        const LAS unsigned char* slot = xl + (cnt & 1) * 8192; ++cnt;
        float rs[2][4];
#pragma unroll
        for (int ai = 0; ai < 2; ++ai)
#pragma unroll
            for (int m = 0; m < 4; ++m) rs[ai][m] = lds_rstd(slot, ai * 128 + wr * 64 + 4 * fr + m);
#pragma unroll
        for (int n = 0; n < 2; ++n) {
            const int jg = jg0 + 16 * n;
            const LAS unsigned char* wl = slot + (cg0 + 16 * n) * 4;
            const f32x4 wg0 = *(const LAS f32x4*)(wl), wg1 = *(const LAS f32x4*)(wl + 512), wg2 = *(const LAS f32x4*)(wl + 1024), bg = *(const LAS f32x4*)(wl + 1536);
            const f32x4 wv0 = *(const LAS f32x4*)(wl + 2048), wv1 = *(const LAS f32x4*)(wl + 2560), wv2 = *(const LAS f32x4*)(wl + 3072), bv = *(const LAS f32x4*)(wl + 3584);
#pragma unroll
            for (int ai = 0; ai < 2; ++ai) {
                f32x4 Gv[4], Vv[4];
#pragma unroll
                for (int m = 0; m < 4; ++m) { Gv[m] = acc[ai][0][m][n] * rs[ai][m]; Vv[m] = acc[ai][1][m][n] * rs[ai][m]; }
                const int blk = u.pm * 4 + ai * 2 + wr;
                bf16* ybp = YB + (size_t)(blk * 4) * NUP + u.pn * 256 + cg0 + 16 * n;
                if (fr == 0) {
#pragma unroll
                    for (int q = 0; q < 2; ++q) { bf16* p = ybp + (size_t)q * NUP; *(u32x2*)p = (u32x2){pk2(Gv[q][0], Gv[q][1]), pk2(Gv[q][2], Gv[q][3])}; *(u32x2*)(p + 128) = (u32x2){pk2(Vv[q][0], Vv[q][1]), pk2(Vv[q][2], Vv[q][3])}; } }
                if (fr == 15) {
#pragma unroll
                    for (int q = 2; q < 4; ++q) { bf16* p = ybp + (size_t)q * NUP; *(u32x2*)p = (u32x2){pk2(Gv[q][0], Gv[q][1]), pk2(Gv[q][2], Gv[q][3])}; *(u32x2*)(p + 128) = (u32x2){pk2(Vv[q][0], Vv[q][1]), pk2(Vv[q][2], Vv[q][3])}; } }
                f32x4 gpre, gnxt, vpre, vnxt;
#pragma unroll
                for (int c = 0; c < 4; ++c) { gpre[c] = dpp0<DPP_SHR1>(Gv[3][c]); gnxt[c] = dpp0<DPP_SHL1>(Gv[0][c]); vpre[c] = dpp0<DPP_SHR1>(Vv[3][c]); vnxt[c] = dpp0<DPP_SHL1>(Vv[0][c]); }
#pragma unroll
                for (int m = 0; m < 4; ++m) {
                    const f32x4 gp = m > 0 ? Gv[m > 0 ? m - 1 : 0] : gpre, gn = m < 3 ? Gv[m < 3 ? m + 1 : 3] : gnxt;
                    const f32x4 vp = m > 0 ? Vv[m > 0 ? m - 1 : 0] : vpre, vn = m < 3 ? Vv[m < 3 ? m + 1 : 3] : vnxt;
                    const f32x4 zg = bg + gp * wg0 + Gv[m] * wg1 + gn * wg2;
                    const f32x4 zv = bv + vp * wv0 + Vv[m] * wv1 + vn * wv2;
                    const f32x4 ov4 = silu4(zg) * zv; const float o0 = ov4[0], o1 = ov4[1], o2 = ov4[2], o3 = ov4[3];
                    const int row = u.pm * 256 + ai * 128 + wr * 64 + 4 * fr + m;
                    *(u32x2*)(ACT + (size_t)row * FF + jg) = (u32x2){pk2(o0, o1), pk2(o2, o3)};
                }
            }
        }
    }
};
__device__ __forceinline__ void transpose_item(const float* W, int K, int N, bf16* WT, LAS float* scr, int item, int lane, const float* gk = nullptr, const bool up_perm = false) {
    const int nblk = N / 32, kb = item / nblk, nb = item % nblk, k0 = 64 * kb, n0 = 32 * nb;
    const int r0 = !up_perm ? n0 : (n0 < FF ? 256 * (n0 >> 7) + (n0 & 127) : 256 * ((n0 - FF) >> 7) + 128 + ((n0 - FF) & 127));
    {
        const int rr = lane >> 3, c4 = (lane & 7) * 4;
        f32x4 v[8]; float gs[8];
#pragma unroll
        for (int i = 0; i < 8; ++i) { v[i] = *(const f32x4*)(W + (size_t)(k0 + rr + 8 * i) * N + n0 + c4); gs[i] = gk ? gk[k0 + rr + 8 * i] : 1.f; }
#pragma unroll
        for (int i = 0; i < 8; ++i) { LAS float* d = scr + (rr + 8 * i) * 33 + c4; d[0] = v[i][0] * gs[i]; d[1] = v[i][1] * gs[i]; d[2] = v[i][2] * gs[i]; d[3] = v[i][3] * gs[i]; }
    }
    asm volatile("s_waitcnt lgkmcnt(0)" ::: "memory");
    const int c = lane & 7;
#pragma unroll
    for (int j = 0; j < 4; ++j) { const int n = (lane >> 3) + 8 * j; const LAS float* s = scr + (8 * c) * 33 + n;
        u32x4 o; o.x = pk2(s[0 * 33], s[1 * 33]); o.y = pk2(s[2 * 33], s[3 * 33]); o.z = pk2(s[4 * 33], s[5 * 33]); o.w = pk2(s[6 * 33], s[7 * 33]);
        *(u32x4*)(WT + (size_t)(r0 + n) * K + k0 + 8 * c) = o; }
    asm volatile("s_waitcnt lgkmcnt(0)" ::: "memory");
}
__device__ __forceinline__ void convert_weights(const Args& a, int l, int which, LAS unsigned char* lds, int gw, int NGW, int wave, int lane) {
    LAS float* scr = (LAS float*)(lds + wave * 16384);
    const float* Win = a.in[2] + (size_t)l * D * NIN; const float* Wout = a.in[12] + (size_t)l * D * D;
    const float* Wup = a.in[14] + (size_t)l * D * NUP; const float* Wdn = a.in[17] + (size_t)l * FF * D;
    bf16* Win_t = (bf16*)(a.ws + WS_WIN); bf16* Wout_t = (bf16*)(a.ws + WS_WOUT); bf16* Wup_t = (bf16*)(a.ws + WS_WUP); bf16* Wdn_t = (bf16*)(a.ws + WS_WDOWN);
    constexpr int I_IN = (D / 64) * (NIN / 32), I_OUT = (D / 64) * (D / 32), I_UP = (D / 64) * (NUP / 32), I_DN = (FF / 64) * (D / 32);
    if (which & 1) {
        for (int it = gw; it < I_IN + I_OUT; it += NGW) {
            if (it < I_IN) transpose_item(Win, D, NIN, Win_t, scr, it, lane, a.in[1] + (size_t)l * D);
            else transpose_item(Wout, D, D, Wout_t, scr, it - I_IN, lane);
        }
        u32x4* pad = (u32x4*)(Win_t + (size_t)NIN * D);
        for (int i = gw * 64 + lane; i < (NINP - NIN) * D / 8; i += NGW * 64) pad[i] = (u32x4){0u, 0u, 0u, 0u};
    }
    if (which & 4) for (int it = gw; it < I_UP; it += NGW) transpose_item(Wup, D, NUP, Wup_t, scr, it, lane, a.in[13] + (size_t)l * D, true);
    if (which & 2) for (int it = gw; it < I_DN; it += NGW) transpose_item(Wdn, FF, D, Wdn_t, scr, it, lane);
}
__device__ __forceinline__ void prologue_rows(const float* X, const float* g, bf16* XN, float* ss, int gw, int NGW, int lane) {
    f32x4 gv[4];
#pragma unroll
    for (int j = 0; j < 4; ++j) gv[j] = ((const f32x4*)g)[lane + 64 * j];
    for (int m = gw; m < M; m += NGW) {
        const f32x4* xr = (const f32x4*)(X + (size_t)m * D) + lane; f32x4 v[4]; float s = 0.f;
#pragma unroll
        for (int j = 0; j < 4; ++j) { v[j] = xr[64 * j]; s += (v[j].x * v[j].x + v[j].y * v[j].y) + (v[j].z * v[j].z + v[j].w * v[j].w); }
        s = wave_sum(s);
        if (lane == 0) *(f32x4*)(ss + (size_t)m * 4) = (f32x4){s, 0.f, 0.f, 0.f};
        unsigned long long* o8 = (unsigned long long*)(XN + (size_t)m * D) + lane;
#pragma unroll
        for (int j = 0; j < 4; ++j) { const f32x4 y = v[j]; o8[64 * j] = (unsigned long long)pk2(y.x, y.y) | ((unsigned long long)pk2(y.z, y.w) << 32); }
    }
}
__device__ __forceinline__ void final_rows(float* X, const float* g, const float* ss, int gw, int NGW, int lane) {
    f32x4 gv[4];
#pragma unroll
    for (int j = 0; j < 4; ++j) gv[j] = ((const f32x4*)g)[lane + 64 * j];
    for (int m = gw; m < M; m += NGW) {
        f32x4* xr = (f32x4*)(X + (size_t)m * D) + lane; const float rstd = row_rstd(ss, m);
#pragma unroll
        for (int j = 0; j < 4; ++j) xr[64 * j] = xr[64 * j] * rstd * gv[j];
    }
}
#define LBAR() do { asm volatile("s_waitcnt lgkmcnt(0)" ::: "memory"); __builtin_amdgcn_s_barrier(); asm volatile("" ::: "memory"); } while (0)
template <int NT, int KS>
__device__ __forceinline__ void mma_rc(const LAS bf16* X, int ldx, int r0, const LAS bf16* Y, int ldy, int c0, f32x4 (&acc)[NT], int lane) {
    const int fr = lane & 15, fq = lane >> 4;
    const LAS bf16* yp = Y + (c0 + fr) * ldy + fq * 8;
    const LAS bf16* xp = X + (r0 + fr) * ldx + fq * 8;
#pragma unroll
    for (int ks = 0; ks < KS; ++ks) {
        const bf16x8 b = *(const LAS bf16x8*)(yp + ks * 32);
#pragma unroll
        for (int t = 0; t < NT; ++t) {
            const bf16x8 a = *(const LAS bf16x8*)(xp + t * 16 * ldx + ks * 32);
            acc[t] = __builtin_amdgcn_mfma_f32_16x16x32_bf16(a, b, acc[t], 0, 0, 0);
        }
    }
}
__device__ __forceinline__ void stage_rbuf(const bf16* P, int row0, LAS unsigned char* lds, int tid) {
    const int r = tid >> 2, part = tid & 3;
    const u32x4 v = *(const u32x4*)(P + (size_t)(row0 + r) * NINP + 2560 + part * 8);
    LAS f32x4* dst = (LAS f32x4*)(lds + RBUF_OFF + (r * 32 + part * 8) * 4);
    dst[0] = (f32x4){bf_lo(v.x), bf_hi(v.x), bf_lo(v.y), bf_hi(v.y)};
    dst[1] = (f32x4){bf_lo(v.z), bf_hi(v.z), bf_lo(v.w), bf_hi(v.w)};
}
template <bool LN>
__device__ __forceinline__ void stage_T(const bf16* P, int row0, int col0, LAS unsigned char* buf, int wave, int lane, const float* lng, const float* lnb) {
    float a[16], b[16];
    const bf16* src = P + (size_t)(row0 + 16 * wave) * NINP + col0 + 2 * lane;
#pragma unroll
    for (int s = 0; s < 16; ++s) { const unsigned v = *(const unsigned*)(src + (size_t)s * NINP); a[s] = bf_lo(v); b[s] = bf_hi(v); }
    if (LN) {
        const f32x2 g = *(const f32x2*)(lng + 2 * lane), bb = *(const f32x2*)(lnb + 2 * lane);
#pragma unroll
        for (int s = 0; s < 16; ++s) {
            const float mu = wave_sum(a[s] + b[s]) * (1.f / 128.f);
            const float da = a[s] - mu, db = b[s] - mu;
            const float rstd = rsqrtf(wave_sum(da * da + db * db) * (1.f / 128.f) + EPS);
            a[s] = da * rstd * g.x + bb.x; b[s] = db * rstd * g.y + bb.y;
        }
    }
    LAS u32x4* d0 = (LAS u32x4*)(buf + ((2 * lane) * LDT + 16 * wave) * 2);
    LAS u32x4* d1 = (LAS u32x4*)(buf + ((2 * lane + 1) * LDT + 16 * wave) * 2);
    d0[0] = (u32x4){pk2(a[0], a[1]), pk2(a[2], a[3]), pk2(a[4], a[5]), pk2(a[6], a[7])};
    d0[1] = (u32x4){pk2(a[8], a[9]), pk2(a[10], a[11]), pk2(a[12], a[13]), pk2(a[14], a[15])};
    d1[0] = (u32x4){pk2(b[0], b[1]), pk2(b[2], b[3]), pk2(b[4], b[5]), pk2(b[6], b[7])};
    d1[1] = (u32x4){pk2(b[8], b[9]), pk2(b[10], b[11]), pk2(b[12], b[13]), pk2(b[14], b[15])};
}
struct CumState { float cf[2][8], cb[2][8], tf[2], tb[2]; };
__device__ __forceinline__ void gate_dir(const float* wg, const float* bgp, const LAS unsigned char* rb, float (&la)[2][8]) {
    f32x2 wv[16];
#pragma unroll
    for (int t = 0; t < 16; ++t) wv[t] = *(const f32x2*)(wg + t * 256);
    const f32x2 bv = *(const f32x2*)bgp;
#pragma unroll
    for (int s = 0; s < 8; ++s) {
        const LAS f32x4* r = (const LAS f32x4*)(rb + s * 128);
        f32x2 pp = bv;
#pragma unroll
        for (int q = 0; q < 4; ++q) { const f32x4 rv = r[q];
#pragma unroll
            for (int e = 0; e < 4; ++e) pp = __builtin_elementwise_fma((f32x2){rv[e], rv[e]}, wv[4 * q + e], pp); }
        la[0][s] = logsig_f(pp.x) * (0.0625f * 1.44269504089f); la[1][s] = logsig_f(pp.y) * (0.0625f * 1.44269504089f);
        if (s & 1) __builtin_amdgcn_sched_barrier(0);
    }
}
__device__ __forceinline__ void compute_cum(const Args& a, int l, int h, LAS unsigned char* lds, int wave, int lane, CumState& C) {
    const int p = lane & 31, seg = 2 * wave + (lane >> 5);
    const int co = l * 256 + h * 64 + 2 * p;
    const LAS unsigned char* rb = lds + RBUF_OFF + (8 * seg) * 128;
    gate_dir(a.in[7] + (size_t)l * 16 * 256 + h * 64 + 2 * p, a.in[8] + co, rb, C.cf);
    { float r0 = 0.f, r1 = 0.f;
#pragma unroll
      for (int s = 0; s < 8; ++s) { r0 += C.cf[0][s]; r1 += C.cf[1][s]; C.cf[0][s] = r0; C.cf[1][s] = r1; } }
    __builtin_amdgcn_sched_barrier(0);
    gate_dir(a.in[9] + (size_t)l * 16 * 256 + h * 64 + 2 * p, a.in[10] + co, rb + 64, C.cb);
    { float r0 = 0.f, r1 = 0.f;
#pragma unroll
      for (int s = 7; s >= 0; --s) { r0 += C.cb[0][s]; r1 += C.cb[1][s]; C.cb[0][s] = r0; C.cb[1][s] = r1; } }
    __builtin_amdgcn_sched_barrier(0);
    LAS float* tot = (LAS float*)(lds + TOT_OFF);
    *(LAS f32x2*)(tot + seg * 64 + 2 * p) = (f32x2){C.cf[0][7], C.cf[1][7]};
    *(LAS f32x2*)(tot + (16 + seg) * 64 + 2 * p) = (f32x2){C.cb[0][0], C.cb[1][0]};
    LBAR();
    float of0 = 0.f, of1 = 0.f, tf0 = 0.f, tf1 = 0.f, ob0 = 0.f, ob1 = 0.f, tb0 = 0.f, tb1 = 0.f;
#pragma unroll
    for (int sg = 0; sg < 16; ++sg) {
        const f32x2 x = *(const LAS f32x2*)(tot + sg * 64 + 2 * p), y = *(const LAS f32x2*)(tot + (16 + sg) * 64 + 2 * p);
        tf0 += x.x; tf1 += x.y; tb0 += y.x; tb1 += y.y;
        if (sg < seg) { of0 += x.x; of1 += x.y; }
        if (sg > seg) { ob0 += y.x; ob1 += y.y; }
    }
#pragma unroll
    for (int s = 0; s < 8; ++s) { C.cf[0][s] += of0; C.cf[1][s] += of1; C.cb[0][s] += ob0; C.cb[1][s] += ob1; }
    C.tf[0] = tf0; C.tf[1] = tf1; C.tb[0] = tb0; C.tb[1] = tb1;
    __builtin_amdgcn_sched_barrier(0);
}
__device__ __forceinline__ void mixer_a_item(const Args& a, int l, int item, LAS unsigned char* lds, int tid, int wave, int lane) {
    asm volatile("" : "+v"(tid)); lane = tid & 63;
    const int h = item & 3, row0 = (item >> 2) * 128;
    const bf16* P = (const bf16*)(a.ws + WS_P);
    const int p = lane & 31, seg = 2 * wave + (lane >> 5);
    LBAR();
    unsigned kraw[8];
    { const bf16* kp = P + (size_t)(row0 + 8 * seg) * NINP + 1280 + h * 64 + 2 * p;
#pragma unroll
    for (int s = 0; s < 8; ++s) kraw[s] = *(const unsigned*)(kp + (size_t)s * NINP); }
    stage_rbuf(P, row0, lds, tid);
    stage_T<false>(P, row0, 1536 + h * 128, lds + MB0, wave, lane, nullptr, nullptr);
    LBAR();
    CumState C; compute_cum(a, l, h, lds, wave, lane, C);
    { f32x4* cq = (f32x4*)(a.ws + WS_CUM) + (size_t)item * 4096 + tid;
      cq[0] = (f32x4){C.cf[0][0], C.cf[0][1], C.cf[0][2], C.cf[0][3]}; cq[512] = (f32x4){C.cf[0][4], C.cf[0][5], C.cf[0][6], C.cf[0][7]};
      cq[1024] = (f32x4){C.cf[1][0], C.cf[1][1], C.cf[1][2], C.cf[1][3]}; cq[1536] = (f32x4){C.cf[1][4], C.cf[1][5], C.cf[1][6], C.cf[1][7]};
      cq[2048] = (f32x4){C.cb[0][0], C.cb[0][1], C.cb[0][2], C.cb[0][3]}; cq[2560] = (f32x4){C.cb[0][4], C.cb[0][5], C.cb[0][6], C.cb[0][7]};
      cq[3072] = (f32x4){C.cb[1][0], C.cb[1][1], C.cb[1][2], C.cb[1][3]}; cq[3584] = (f32x4){C.cb[1][4], C.cb[1][5], C.cb[1][6], C.cb[1][7]}; }
    float k0[8], k1[8];
#pragma unroll
    for (int s = 0; s < 8; ++s) { k0[s] = bf_lo(kraw[s]); k1[s] = bf_hi(kraw[s]); }
    {
        const f32x2 tf2 = (f32x2){C.tf[0], C.tf[1]}, tb2 = (f32x2){C.tb[0], C.tb[1]};
        float ef0[8], ef1[8], eb0[8], eb1[8];
#pragma unroll
        for (int s = 0; s < 8; ++s) {
            const f32x2 k2 = (f32x2){k0[s], k1[s]};
            const f32x2 af = tf2 - (f32x2){C.cf[0][s], C.cf[1][s]}, ab = tb2 - (f32x2){C.cb[0][s], C.cb[1][s]};
            const f32x2 rf = k2 * (f32x2){__builtin_amdgcn_exp2f(af.x), __builtin_amdgcn_exp2f(af.y)}, rb2 = k2 * (f32x2){__builtin_amdgcn_exp2f(ab.x), __builtin_amdgcn_exp2f(ab.y)};
            ef0[s] = rf.x; ef1[s] = rf.y; eb0[s] = rb2.x; eb1[s] = rb2.y;
        }
        *(LAS u32x4*)(lds + MB2 + ((2 * p) * LDT + 8 * seg) * 2) = (u32x4){pk2(ef0[0], ef0[1]), pk2(ef0[2], ef0[3]), pk2(ef0[4], ef0[5]), pk2(ef0[6], ef0[7])};
        *(LAS u32x4*)(lds + MB2 + ((2 * p + 1) * LDT + 8 * seg) * 2) = (u32x4){pk2(ef1[0], ef1[1]), pk2(ef1[2], ef1[3]), pk2(ef1[4], ef1[5]), pk2(ef1[6], ef1[7])};
        *(LAS u32x4*)(lds + MB2 + ((64 + 2 * p) * LDT + 8 * seg) * 2) = (u32x4){pk2(eb0[0], eb0[1]), pk2(eb0[2], eb0[3]), pk2(eb0[4], eb0[5]), pk2(eb0[6], eb0[7])};
        *(LAS u32x4*)(lds + MB2 + ((64 + 2 * p + 1) * LDT + 8 * seg) * 2) = (u32x4){pk2(eb1[0], eb1[1]), pk2(eb1[2], eb1[3]), pk2(eb1[4], eb1[5]), pk2(eb1[6], eb1[7])};
    }
    if (seg == 0) { float* dec = (float*)(a.ws + WS_DEC) + (size_t)item * 128;
        *(f32x2*)(dec + 2 * p) = (f32x2){__builtin_amdgcn_exp2f(C.tf[0]), __builtin_amdgcn_exp2f(C.tf[1])}; *(f32x2*)(dec + 64 + 2 * p) = (f32x2){__builtin_amdgcn_exp2f(C.tb[0]), __builtin_amdgcn_exp2f(C.tb[1])}; }
    LBAR();
    const int dir = wave >> 2, r0 = 32 * (wave & 3), fr = lane & 15, fq = lane >> 4;
    float* DS = (float*)(a.ws + WS_DS) + (size_t)(item * 2 + dir) * 8192 + (r0 + 4 * fq) * 64 + fr;
#pragma unroll
    for (int n = 0; n < 4; ++n) {
        f32x4 acc[2] = {(f32x4){0.f, 0.f, 0.f, 0.f}, (f32x4){0.f, 0.f, 0.f, 0.f}};
        mma_rc<2, 4>((const LAS bf16*)(lds + MB0), LDT, r0, (const LAS bf16*)(lds + MB2) + dir * 64 * LDT, LDT, 16 * n, acc, lane);
#pragma unroll
        for (int t = 0; t < 2; ++t)
#pragma unroll
            for (int r = 0; r < 4; ++r) DS[(16 * t + r) * 64 + 16 * n] = acc[t][r];
    }
}
__device__ __forceinline__ void mixer_scan(const Args& a, int tid) {
    const float* DS = (const float*)(a.ws + WS_DS); const float* DEC = (const float*)(a.ws + WS_DEC); bf16* ST = (bf16*)(a.ws + WS_ST);
    for (int gid = blockIdx.x * NTHR + tid; gid < 16 * 8192; gid += gridDim.x * NTHR) {
        const int elem = gid & 8191, sq = gid >> 13, b = sq >> 3, h = (sq >> 1) & 3, dir = sq & 1;
        const long blk0 = (long)(((b * 64) * 4 + h) * 2 + dir) + (dir ? 63 * 8 : 0); const long bstep = dir ? -8 : 8;
        const float* dsp = DS + blk0 * 8192 + elem; const float* dcp = DEC + blk0 * 64 + (elem & 63); bf16* stp = ST + blk0 * 8192 + elem;
        float ds[64], dc[64];
#pragma unroll
        for (int s = 0; s < 64; ++s) { ds[s] = dsp[(long)s * bstep * 8192]; dc[s] = dcp[(long)s * bstep * 64]; }
        float S = 0.f;
#pragma unroll
        for (int s = 0; s < 64; ++s) { stp[(long)s * bstep * 8192] = (bf16)f2bf(S); S = S * dc[s] + ds[s]; }
    }
}
__device__ __forceinline__ void mixer_c_gla(const Args& a, int l, int item, LAS unsigned char* lds, int tid, int wave, int lane) {
    asm volatile("" : "+v"(tid)); lane = tid & 63;
    const int h = item & 3, row0 = (item >> 2) * 128;
    const bf16* P = (const bf16*)(a.ws + WS_P); bf16* MIX = (bf16*)(a.ws + WS_MIX); const bf16* ST = (const bf16*)(a.ws + WS_ST);
    __syncthreads();
    stage_rbuf(P, row0, lds, tid);
    stage_T<false>(P, row0, 1536 + h * 128, lds + MB0, wave, lane, nullptr, nullptr);
    __syncthreads();
    CumState C; compute_cum(a, l, h, lds, wave, lane, C);
    const int p = lane & 31, seg = 2 * wave + (lane >> 5);
    const bf16* prb = P + (size_t)(row0 + 8 * seg) * NINP + h * 64 + 2 * p;
    LAS unsigned char* qdb = lds + MB2 + (8 * seg * LDT + 2 * p) * 2; LAS unsigned char* kib = lds + MB3 + (8 * seg * LDK + 2 * p) * 2;
#pragma unroll
    for (int s = 0; s < 8; ++s) {
        const bf16* pr = prb + (size_t)s * NINP;
        const unsigned qv = *(const unsigned*)(pr + 1024), kv = *(const unsigned*)(pr + 1280);
        const float q0 = bf_lo(qv), q1 = bf_hi(qv), k0 = bf_lo(kv), k1 = bf_hi(kv);
        *(LAS unsigned*)(qdb + s * LDT * 2) = pk2(q0 * __expf(C.cf[0][s]), q1 * __expf(C.cf[1][s]));
        *(LAS unsigned*)(qdb + s * LDT * 2 + 128) = pk2(q0 * __expf(C.cb[0][s]), q1 * __expf(C.cb[1][s]));
        *(LAS unsigned*)(kib + s * LDK * 2) = pk2(k0 * __expf(-C.cf[0][s]), k1 * __expf(-C.cf[1][s]));
        *(LAS unsigned*)(kib + (128 + s) * LDK * 2) = pk2(k0 * __expf(-C.cb[0][s]), k1 * __expf(-C.cb[1][s]));
        if (s & 1) __builtin_amdgcn_sched_barrier(0);
    }
    __syncthreads();
    const int fr = lane & 15, fq = lane >> 4, w = wave;
#pragma unroll
    for (int t = 0; t < 8; ++t) {
        f32x4 sf[1] = {(f32x4){0.f, 0.f, 0.f, 0.f}}, sb[1] = {(f32x4){0.f, 0.f, 0.f, 0.f}};
        if (t <= w) mma_rc<1, 2>((const LAS bf16*)(lds + MB3), LDK, 16 * t, (const LAS bf16*)(lds + MB2), LDT, 16 * w, sf, lane);
        if (t >= w) mma_rc<1, 2>((const LAS bf16*)(lds + MB3) + 128 * LDK, LDK, 16 * t, (const LAS bf16*)(lds + MB2) + 64, LDT, 16 * w, sb, lane);
        const int i = 16 * w + fr, j0 = 16 * t + 4 * fq;
        float v[4];
#pragma unroll
        for (int r = 0; r < 4; ++r) v[r] = (j0 + r <= i) ? sf[0][r] : sb[0][r];
        *(LAS u32x2*)(lds + MB1 + (i * LDT + 4 * fq) * 2 + 32 * t) = (u32x2){pk2(v[0], v[1]), pk2(v[2], v[3])};
    }
    __syncthreads();
#pragma unroll
    for (int q = 0; q < 4; ++q) { const int c = tid + NTHR * q, dir = c >> 10, cc = c & 1023, e = cc >> 3, part = cc & 7;
        const u32x4 v = *(const u32x4*)(ST + (size_t)(item * 2 + dir) * 8192 + e * 64 + part * 8);
        *(LAS u32x4*)(lds + MB3 + (e * LDT + dir * 64 + part * 8) * 2) = v; }
    f32x4 acc[8];
#pragma unroll
    for (int t = 0; t < 8; ++t) acc[t] = (f32x4){0.f, 0.f, 0.f, 0.f};
    mma_rc<8, 4>((const LAS bf16*)(lds + MB0), LDT, 0, (const LAS bf16*)(lds + MB1), LDT, 16 * w, acc, lane);
    __syncthreads();
    mma_rc<8, 4>((const LAS bf16*)(lds + MB3), LDT, 0, (const LAS bf16*)(lds + MB2), LDT, 16 * w, acc, lane);
    float ss = 0.f;
#pragma unroll
    for (int t = 0; t < 8; ++t) ss += (acc[t][0] * acc[t][0] + acc[t][1] * acc[t][1]) + (acc[t][2] * acc[t][2] + acc[t][3] * acc[t][3]);
    ss += __shfl_xor(ss, 16); ss += __shfl_xor(ss, 32);
    const float rstd = rsqrtf(ss * (1.f / 128.f) + EPS);
    const int row = row0 + 16 * w + fr;
    const bf16* pg = P + (size_t)row * NINP + 2048 + h * 128 + 4 * fq; const float* gg = a.in[11] + (size_t)(l * 4 + h) * 128 + 4 * fq;
    bf16* mo = MIX + (size_t)row * D + 512 + h * 128 + 4 * fq;
#pragma unroll
    for (int t = 0; t < 8; ++t) { const u32x2 gv = *(const u32x2*)(pg + 16 * t); const f32x4 g4 = *(const f32x4*)(gg + 16 * t);
        const float o0 = acc[t][0] * rstd * g4[0] * silu_f(bf_lo(gv.x)), o1 = acc[t][1] * rstd * g4[1] * silu_f(bf_hi(gv.x));
        const float o2 = acc[t][2] * rstd * g4[2] * silu_f(bf_lo(gv.y)), o3 = acc[t][3] * rstd * g4[3] * silu_f(bf_hi(gv.y));
        *(u32x2*)(mo + 16 * t) = (u32x2){pk2(o0, o1), pk2(o2, o3)}; }
}
__device__ __forceinline__ void mixer_c_gmlp(const Args& a, int l, int item, LAS unsigned char* lds, int tid, int wave, int lane) {
    asm volatile("" : "+v"(tid)); lane = tid & 63;
    const int h = item & 3, row0 = (item >> 2) * 128;
    const bf16* P = (const bf16*)(a.ws + WS_P); bf16* MIX = (bf16*)(a.ws + WS_MIX);
    __syncthreads();
    { const float* Ws = a.in[3] + (size_t)(l * 4 + h) * 16384; const int r = tid >> 2, cp = (tid & 3) * 32;
#pragma unroll
      for (int q = 0; q < 4; ++q) { const f32x4 x0 = *(const f32x4*)(Ws + r * 128 + cp + 8 * q), x1 = *(const f32x4*)(Ws + r * 128 + cp + 8 * q + 4);
          *(LAS u32x4*)(lds + MB1 + (r * LDT + cp + 8 * q) * 2) = (u32x4){pk2(x0[0], x0[1]), pk2(x0[2], x0[3]), pk2(x1[0], x1[1]), pk2(x1[2], x1[3])}; } }
    stage_T<true>(P, row0, 512 + h * 128, lds + MB0, wave, lane, a.in[5] + (size_t)(l * 4 + h) * 128, a.in[6] + (size_t)(l * 4 + h) * 128);
    __syncthreads();
    const int fr = lane & 15, fq = lane >> 4, w = wave;
    f32x4 acc[8];
#pragma unroll
    for (int t = 0; t < 8; ++t) acc[t] = (f32x4){0.f, 0.f, 0.f, 0.f};
    mma_rc<8, 4>((const LAS bf16*)(lds + MB0), LDT, 0, (const LAS bf16*)(lds + MB1), LDT, 16 * w, acc, lane);
    const float bsv = a.in[4][(size_t)(l * 4 + h) * 128 + 16 * w + fr];
    const int row = row0 + 16 * w + fr;
    const bf16* up = P + (size_t)row * NINP + h * 128 + 4 * fq; bf16* mo = MIX + (size_t)row * D + h * 128 + 4 * fq;
#pragma unroll
    for (int t = 0; t < 8; ++t) { const u32x2 uv = *(const u32x2*)(up + 16 * t);
        const float o0 = bf_lo(uv.x) * (acc[t][0] + bsv), o1 = bf_hi(uv.x) * (acc[t][1] + bsv), o2 = bf_lo(uv.y) * (acc[t][2] + bsv), o3 = bf_hi(uv.y) * (acc[t][3] + bsv);
        *(u32x2*)(mo + 16 * t) = (u32x2){pk2(o0, o1), pk2(o2, o3)}; }
}
__device__ __forceinline__ void mixer_gla_item(const Args& a, int l, int item, LAS unsigned char* lds, int tid, int wave, int lane, const XcdBarrier& xb, const bool first) {
    asm volatile("" : "+v"(tid)); lane = tid & 63;
    const int h = item & 3, row0 = (item >> 2) * 128;
    const bf16* P = (const bf16*)(a.ws + WS_P); bf16* MIX = (bf16*)(a.ws + WS_MIX); const bf16* ST = (const bf16*)(a.ws + WS_ST);
    const int p = lane & 31, seg = 2 * wave + (lane >> 5), fr = lane & 15, fq = lane >> 4, w = wave;
    const int orow = row0 + 16 * w + fr;
    LBAR();
    unsigned vraw[16];
    { const bf16* src = P + (size_t)(row0 + 16 * wave) * NINP + 1536 + h * 128 + 2 * lane;
#pragma unroll
      for (int s = 0; s < 16; ++s) vraw[s] = *(const unsigned*)(src + (size_t)s * NINP); }
    unsigned qv[8], kv[8];
    { const bf16* prb = P + (size_t)(row0 + 8 * seg) * NINP + h * 64 + 2 * p;
#pragma unroll
      for (int s = 0; s < 8; ++s) { qv[s] = *(const unsigned*)(prb + (size_t)s * NINP + 1024); kv[s] = *(const unsigned*)(prb + (size_t)s * NINP + 1280); } }
    f32x4 cq[8];
    { const f32x4* cp = (const f32x4*)(a.ws + WS_CUM) + (size_t)item * 4096 + tid;
#pragma unroll
      for (int j = 0; j < 8; ++j) cq[j] = cp[512 * j]; }
    u32x2 pgv[8];
    { const bf16* pg = P + (size_t)orow * NINP + 2048 + h * 128 + 4 * fq;
#pragma unroll
      for (int t = 0; t < 8; ++t) pgv[t] = *(const u32x2*)(pg + 16 * t); }
    { LAS u32x4* d0 = (LAS u32x4*)(lds + MB0 + ((2 * lane) * LDT + 16 * wave) * 2); LAS u32x4* d1 = (LAS u32x4*)(lds + MB0 + ((2 * lane + 1) * LDT + 16 * wave) * 2);
#define LO2(x, y) (((x) & 0xffffu) | ((y) << 16))
#define HI2(x, y) (((x) >> 16) | ((y) & 0xffff0000u))
      d0[0] = (u32x4){LO2(vraw[0], vraw[1]), LO2(vraw[2], vraw[3]), LO2(vraw[4], vraw[5]), LO2(vraw[6], vraw[7])};
      d0[1] = (u32x4){LO2(vraw[8], vraw[9]), LO2(vraw[10], vraw[11]), LO2(vraw[12], vraw[13]), LO2(vraw[14], vraw[15])};
      d1[0] = (u32x4){HI2(vraw[0], vraw[1]), HI2(vraw[2], vraw[3]), HI2(vraw[4], vraw[5]), HI2(vraw[6], vraw[7])};
      d1[1] = (u32x4){HI2(vraw[8], vraw[9]), HI2(vraw[10], vraw[11]), HI2(vraw[12], vraw[13]), HI2(vraw[14], vraw[15])}; }
    CumState C;
#pragma unroll
    for (int q = 0; q < 4; ++q) { C.cf[0][q] = cq[0][q]; C.cf[0][4 + q] = cq[1][q]; C.cf[1][q] = cq[2][q]; C.cf[1][4 + q] = cq[3][q]; C.cb[0][q] = cq[4][q]; C.cb[0][4 + q] = cq[5][q]; C.cb[1][q] = cq[6][q]; C.cb[1][4 + q] = cq[7][q]; }
    { LAS unsigned char* qdb = lds + MB2 + (8 * seg * LDT + 2 * p) * 2; LAS unsigned char* kib = lds + MB3 + (8 * seg * LDK + 2 * p) * 2;
#pragma unroll
      for (int s = 0; s < 8; ++s) {
        const f32x2 q2 = (f32x2){bf_lo(qv[s]), bf_hi(qv[s])}, k2 = (f32x2){bf_lo(kv[s]), bf_hi(kv[s])};
        const f32x2 ef = (f32x2){__builtin_amdgcn_exp2f(C.cf[0][s]), __builtin_amdgcn_exp2f(C.cf[1][s])}, eb = (f32x2){__builtin_amdgcn_exp2f(C.cb[0][s]), __builtin_amdgcn_exp2f(C.cb[1][s])};
        const f32x2 nf = (f32x2){__builtin_amdgcn_exp2f(-C.cf[0][s]), __builtin_amdgcn_exp2f(-C.cf[1][s])}, nb = (f32x2){__builtin_amdgcn_exp2f(-C.cb[0][s]), __builtin_amdgcn_exp2f(-C.cb[1][s])};
        const f32x2 qf = q2 * ef, qb = q2 * eb, kf = k2 * nf, kb = k2 * nb;
        *(LAS unsigned*)(qdb + s * LDT * 2) = pk2(qf.x, qf.y);
        *(LAS unsigned*)(qdb + s * LDT * 2 + 128) = pk2(qb.x, qb.y);
        *(LAS unsigned*)(kib + s * LDK * 2) = pk2(kf.x, kf.y);
        *(LAS unsigned*)(kib + (128 + s) * LDK * 2) = pk2(kb.x, kb.y);
        if (s & 1) __builtin_amdgcn_sched_barrier(0);
      } }
    LBAR();
    if (first) xcd_wait(xb, tid);
    u32x4 stv[4];
#pragma unroll
    for (int q = 0; q < 4; ++q) { const int c = tid + NTHR * q, dir = c >> 10, cc = c & 1023; stv[q] = *(const u32x4*)(ST + (size_t)(item * 2 + dir) * 8192 + (cc >> 3) * 64 + (cc & 7) * 8); }
#pragma unroll
    for (int t = 0; t < 8; ++t) {
        f32x4 sf[1] = {(f32x4){0.f, 0.f, 0.f, 0.f}}, sb[1] = {(f32x4){0.f, 0.f, 0.f, 0.f}};
        if (t <= w) mma_rc<1, 2>((const LAS bf16*)(lds + MB3), LDK, 16 * t, (const LAS bf16*)(lds + MB2), LDT, 16 * w, sf, lane);
        if (t >= w) mma_rc<1, 2>((const LAS bf16*)(lds + MB3) + 128 * LDK, LDK, 16 * t, (const LAS bf16*)(lds + MB2) + 64, LDT, 16 * w, sb, lane);
        const int i = 16 * w + fr, j0 = 16 * t + 4 * fq;
        float v[4];
#pragma unroll
        for (int r = 0; r < 4; ++r) v[r] = (j0 + r <= i) ? sf[0][r] : sb[0][r];
        *(LAS u32x2*)(lds + MB1 + (i * LDT + 4 * fq) * 2 + 32 * t) = (u32x2){pk2(v[0], v[1]), pk2(v[2], v[3])};
    }
    LBAR();
#pragma unroll
    for (int q = 0; q < 4; ++q) { const int c = tid + NTHR * q, dir = c >> 10, cc = c & 1023; *(LAS u32x4*)(lds + MB3 + ((cc >> 3) * LDT + dir * 64 + (cc & 7) * 8) * 2) = stv[q]; }
    f32x4 acc[8];
#pragma unroll
    for (int t = 0; t < 8; ++t) acc[t] = (f32x4){0.f, 0.f, 0.f, 0.f};
    mma_rc<8, 4>((const LAS bf16*)(lds + MB0), LDT, 0, (const LAS bf16*)(lds + MB1), LDT, 16 * w, acc, lane);
    LBAR();
    mma_rc<8, 4>((const LAS bf16*)(lds + MB3), LDT, 0, (const LAS bf16*)(lds + MB2), LDT, 16 * w, acc, lane);
    {   float ss = 0.f;
        { f32x4 s4 = acc[0] * acc[0];
#pragma unroll
          for (int t = 1; t < 8; ++t) s4 = __builtin_elementwise_fma(acc[t], acc[t], s4);
          ss = (s4[0] + s4[1]) + (s4[2] + s4[3]); }
        ss += __shfl_xor(ss, 16); ss += __shfl_xor(ss, 32);
        const float rstd = rsqrtf(ss * (1.f / 128.f) + EPS);
        const float* gg = a.in[11] + (size_t)(l * 4 + h) * 128 + 4 * fq; bf16* mo = MIX + (size_t)orow * D + 512 + h * 128 + 4 * fq;
        f32x4 g4a[8];
#pragma unroll
        for (int t = 0; t < 8; ++t) g4a[t] = *(const f32x4*)(gg + 16 * t);
#pragma unroll
        for (int t = 0; t < 8; ++t) { const f32x4 g4 = g4a[t];
            const f32x4 ov4 = (acc[t] * rstd) * g4 * silu4((f32x4){bf_lo(pgv[t].x), bf_hi(pgv[t].x), bf_lo(pgv[t].y), bf_hi(pgv[t].y)});
            const float o0 = ov4[0], o1 = ov4[1], o2 = ov4[2], o3 = ov4[3];
            *(u32x2*)(mo + 16 * t) = (u32x2){pk2(o0, o1), pk2(o2, o3)}; } }
}
__device__ __forceinline__ void mixer_gmlp_item(const Args& a, int l, int item, LAS unsigned char* lds, int tid, int wave, int lane) {
    asm volatile("" : "+v"(tid)); lane = tid & 63;
    const int h = item & 3, row0 = (item >> 2) * 128;
    const bf16* P = (const bf16*)(a.ws + WS_P); bf16* MIX = (bf16*)(a.ws + WS_MIX);
    const int fr = lane & 15, fq = lane >> 4, w = wave;
    const int orow = row0 + 16 * w + fr;
    LBAR();
    f32x4 wsv[8];
    { const float* Ws = a.in[3] + (size_t)(l * 4 + h) * 16384 + (tid >> 2) * 128 + (tid & 3) * 32;
#pragma unroll
      for (int q = 0; q < 8; ++q) wsv[q] = *(const f32x4*)(Ws + 4 * q); }
    unsigned araw[16];
    { const bf16* src = P + (size_t)(row0 + 16 * wave) * NINP + 512 + h * 128 + 2 * lane;
#pragma unroll
      for (int s = 0; s < 16; ++s) araw[s] = *(const unsigned*)(src + (size_t)s * NINP); }
    u32x2 uv[8];
    { const bf16* up = P + (size_t)orow * NINP + h * 128 + 4 * fq;
#pragma unroll
      for (int t = 0; t < 8; ++t) uv[t] = *(const u32x2*)(up + 16 * t); }
    { const int r = tid >> 2, cp = (tid & 3) * 32;
#pragma unroll
      for (int q = 0; q < 4; ++q) *(LAS u32x4*)(lds + MB1 + (r * LDT + cp + 8 * q) * 2) = (u32x4){pk2(wsv[2 * q][0], wsv[2 * q][1]), pk2(wsv[2 * q][2], wsv[2 * q][3]), pk2(wsv[2 * q + 1][0], wsv[2 * q + 1][1]), pk2(wsv[2 * q + 1][2], wsv[2 * q + 1][3])}; }
    { float av[16], bv[16];
      const f32x2 g = *(const f32x2*)(a.in[5] + (size_t)(l * 4 + h) * 128 + 2 * lane), bb = *(const f32x2*)(a.in[6] + (size_t)(l * 4 + h) * 128 + 2 * lane);
#pragma unroll
      for (int s = 0; s < 16; ++s) {
          const f32x2 xv = (f32x2){bf_lo(araw[s]), bf_hi(araw[s])};
          const float mu = wave_sum_dpp(xv.x + xv.y) * (1.f / 128.f);
          const f32x2 dv = xv - mu, sq = dv * dv;
          const float rstd = rsqrtf(wave_sum_dpp(sq.x + sq.y) * (1.f / 128.f) + EPS);
          const f32x2 ov2 = __builtin_elementwise_fma(dv * rstd, g, bb);
          av[s] = ov2.x; bv[s] = ov2.y;
      }
      LAS u32x4* d0 = (LAS u32x4*)(lds + MB0 + ((2 * lane) * LDT + 16 * wave) * 2); LAS u32x4* d1 = (LAS u32x4*)(lds + MB0 + ((2 * lane + 1) * LDT + 16 * wave) * 2);
      d0[0] = (u32x4){pk2(av[0], av[1]), pk2(av[2], av[3]), pk2(av[4], av[5]), pk2(av[6], av[7])};
      d0[1] = (u32x4){pk2(av[8], av[9]), pk2(av[10], av[11]), pk2(av[12], av[13]), pk2(av[14], av[15])};
      d1[0] = (u32x4){pk2(bv[0], bv[1]), pk2(bv[2], bv[3]), pk2(bv[4], bv[5]), pk2(bv[6], bv[7])};
      d1[1] = (u32x4){pk2(bv[8], bv[9]), pk2(bv[10], bv[11]), pk2(bv[12], bv[13]), pk2(bv[14], bv[15])}; }
    LBAR();
    f32x4 acc[8];
#pragma unroll
    for (int t = 0; t < 8; ++t) acc[t] = (f32x4){0.f, 0.f, 0.f, 0.f};
    mma_rc<8, 4>((const LAS bf16*)(lds + MB0), LDT, 0, (const LAS bf16*)(lds + MB1), LDT, 16 * w, acc, lane);
    {   const float bsv = a.in[4][(size_t)(l * 4 + h) * 128 + 16 * w + fr];
        bf16* mo = MIX + (size_t)orow * D + h * 128 + 4 * fq;
#pragma unroll
        for (int t = 0; t < 8; ++t) {
            const f32x4 ov4 = (f32x4){bf_lo(uv[t].x), bf_hi(uv[t].x), bf_lo(uv[t].y), bf_hi(uv[t].y)} * (acc[t] + bsv); const float o0 = ov4[0], o1 = ov4[1], o2 = ov4[2], o3 = ov4[3];
            *(u32x2*)(mo + 16 * t) = (u32x2){pk2(o0, o1), pk2(o2, o3)}; } }
}
__device__ __forceinline__ void unpack8(const u32x4 v, float (&f)[8]) { f[0] = bf_lo(v.x); f[1] = bf_hi(v.x); f[2] = bf_lo(v.y); f[3] = bf_hi(v.y); f[4] = bf_lo(v.z); f[5] = bf_hi(v.z); f[6] = bf_lo(v.w); f[7] = bf_hi(v.w); }
__device__ __forceinline__ void conv_act(const Args& a, int l, int tid) {
    const bf16* Y = (const bf16*)(a.ws + WS_R1); bf16* ACT = (bf16*)(a.ws + WS_R2);
    const float* cw = a.in[15] + (size_t)l * 3 * NUP; const float* cb = a.in[16] + (size_t)l * NUP;
    constexpr int NCG = FF / 8, NT = (M / 8) * NCG;
    for (int t = blockIdx.x * NTHR + tid; t < NT; t += gridDim.x * NTHR) {
        const int cgp = t % NCG, rg = t / NCG, j0 = cgp * 8, m0 = rg * 8, pos = m0 & (SEQ - 1);
        float wg[3][8], wv[3][8], bg[8], bv[8];
#pragma unroll
        for (int k = 0; k < 3; ++k)
#pragma unroll
            for (int q = 0; q < 2; ++q) { const f32x4 x = *(const f32x4*)(cw + k * NUP + j0 + 4 * q), y = *(const f32x4*)(cw + k * NUP + FF + j0 + 4 * q);
#pragma unroll
                for (int e = 0; e < 4; ++e) { wg[k][4 * q + e] = x[e]; wv[k][4 * q + e] = y[e]; } }
#pragma unroll
        for (int q = 0; q < 2; ++q) { const f32x4 x = *(const f32x4*)(cb + j0 + 4 * q), y = *(const f32x4*)(cb + FF + j0 + 4 * q);
#pragma unroll
            for (int e = 0; e < 4; ++e) { bg[4 * q + e] = x[e]; bv[4 * q + e] = y[e]; } }
        float pg[8], pv[8], cgv[8], cv[8], ng[8], nv[8];
        const bf16* yr = Y + (size_t)m0 * NUP + j0;
        if (pos > 0) { unpack8(*(const u32x4*)(yr - NUP), pg); unpack8(*(const u32x4*)(yr - NUP + FF), pv); }
        else {
#pragma unroll
            for (int e = 0; e < 8; ++e) { pg[e] = 0.f; pv[e] = 0.f; } }
        unpack8(*(const u32x4*)(yr), cgv); unpack8(*(const u32x4*)(yr + FF), cv);
#pragma unroll
        for (int r = 0; r < 8; ++r) {
            if (r < 7 || pos + 8 < SEQ) { unpack8(*(const u32x4*)(yr + (size_t)(r + 1) * NUP), ng); unpack8(*(const u32x4*)(yr + (size_t)(r + 1) * NUP + FF), nv); }
            else {
#pragma unroll
                for (int e = 0; e < 8; ++e) { ng[e] = 0.f; nv[e] = 0.f; } }
            float o[8];
#pragma unroll
            for (int e = 0; e < 8; ++e) { const float zg = bg[e] + pg[e] * wg[0][e] + cgv[e] * wg[1][e] + ng[e] * wg[2][e];
                const float zv = bv[e] + pv[e] * wv[0][e] + cv[e] * wv[1][e] + nv[e] * wv[2][e]; o[e] = silu_f(zg) * zv; }
            *(u32x4*)(ACT + (size_t)(m0 + r) * FF + j0) = (u32x4){pk2(o[0], o[1]), pk2(o[2], o[3]), pk2(o[4], o[5]), pk2(o[6], o[7])};
#pragma unroll
            for (int e = 0; e < 8; ++e) { pg[e] = cgv[e]; pv[e] = cv[e]; cgv[e] = ng[e]; cv[e] = nv[e]; }
        }
    }
}

__device__ __forceinline__ void conv_fix(const Args& a, int l, int tid) {
    const bf16* YB = (const bf16*)(a.ws + WS_R1); bf16* ACT = (bf16*)(a.ws + WS_R2);
    const float* cw = a.in[15] + (size_t)l * 3 * NUP; const float* cb = a.in[16] + (size_t)l * NUP;
    constexpr int NCG = FF / 8, NT = (M / 64) * 2 * NCG;
    for (int t = blockIdx.x * NTHR + tid; t < NT; t += gridDim.x * NTHR) {
        const int cgp = t % NCG, bw = t / NCG, which = bw & 1, blk = bw >> 1, j0 = cgp * 8;
        const int colg = 256 * (j0 >> 7) + (j0 & 127), row = blk * 64 + (which ? 63 : 0), pos = row & (SEQ - 1);
        float wg[3][8], wv[3][8], bg[8], bv[8];
#pragma unroll
        for (int k = 0; k < 3; ++k)
#pragma unroll
            for (int q = 0; q < 2; ++q) { const f32x4 x = *(const f32x4*)(cw + k * NUP + j0 + 4 * q), y = *(const f32x4*)(cw + k * NUP + FF + j0 + 4 * q);
#pragma unroll
                for (int e = 0; e < 4; ++e) { wg[k][4 * q + e] = x[e]; wv[k][4 * q + e] = y[e]; } }
#pragma unroll
        for (int q = 0; q < 2; ++q) { const f32x4 x = *(const f32x4*)(cb + j0 + 4 * q), y = *(const f32x4*)(cb + FF + j0 + 4 * q);
#pragma unroll
            for (int e = 0; e < 4; ++e) { bg[4 * q + e] = x[e]; bv[4 * q + e] = y[e]; } }
        const bf16* yb = YB + (size_t)(blk * 4) * NUP + colg;
        const bf16* pp = which ? yb + 2 * (size_t)NUP : yb - (size_t)NUP;
        const bf16* cp = which ? yb + 3 * (size_t)NUP : yb;
        const bf16* np = which ? yb + 4 * (size_t)NUP : yb + (size_t)NUP;
        const bool hasp = which || pos > 0, hasn = !which || pos < SEQ - 1;
        float pg[8], pv[8], cgv[8], cv[8], ng[8], nv[8];
        if (hasp) { unpack8(*(const u32x4*)pp, pg); unpack8(*(const u32x4*)(pp + 128), pv); }
        else {
#pragma unroll
            for (int e = 0; e < 8; ++e) { pg[e] = 0.f; pv[e] = 0.f; } }
        unpack8(*(const u32x4*)cp, cgv); unpack8(*(const u32x4*)(cp + 128), cv);
        if (hasn) { unpack8(*(const u32x4*)np, ng); unpack8(*(const u32x4*)(np + 128), nv); }
        else {
#pragma unroll
            for (int e = 0; e < 8; ++e) { ng[e] = 0.f; nv[e] = 0.f; } }
        float o[8];
#pragma unroll
        for (int e = 0; e < 8; ++e) { const float zg = bg[e] + pg[e] * wg[0][e] + cgv[e] * wg[1][e] + ng[e] * wg[2][e];
            const float zv = bv[e] + pv[e] * wv[0][e] + cv[e] * wv[1][e] + nv[e] * wv[2][e]; o[e] = silu_f(zg) * zv; }
        *(u32x4*)(ACT + (size_t)row * FF + j0) = (u32x4){pk2(o[0], o[1]), pk2(o[2], o[3]), pk2(o[4], o[5]), pk2(o[6], o[7])};
    }
}

#ifndef DUP_MASK
#define DUP_MASK 0
#endif
typedef const __attribute__((address_space(4))) Args* KArgsPtr;
__device__ __forceinline__ const Args& kargs() { KArgsPtr p = (KArgsPtr)__builtin_amdgcn_kernarg_segment_ptr(); asm volatile("" : "+s"(p)); return *(const Args*)p; }
__device__ __forceinline__ int lane_id() { return (int)__builtin_amdgcn_mbcnt_hi(~0u, __builtin_amdgcn_mbcnt_lo(~0u, 0u)); }
constexpr int NPH_L = 8;
template <int L, int S>
__device__ __forceinline__ void phase_body(LAS unsigned char* lds, const int wave_s, const XcdBarrier& xb) {
    const Args& a = kargs();
    int lane = lane_id(); asm volatile("" : "+v"(lane));
    const int wave = wave_s, tid = wave * 64 + lane, gw = blockIdx.x * 8 + wave;
    const int G = gridDim.x, NGW = G * 8;
    bf16* XB = (bf16*)(a.ws + WS_XB); bf16* Pb = (bf16*)(a.ws + WS_P); bf16* MIX = (bf16*)(a.ws + WS_MIX); bf16* Yb = (bf16*)(a.ws + WS_R1); bf16* ACT = (bf16*)(a.ws + WS_R2);
    float* SSM = (float*)(a.ws + WS_SSM); float* SSF = (float*)(a.ws + WS_SSF);
    const bf16* Win_t = (const bf16*)(a.ws + WS_WIN); const bf16* Wout_t = (const bf16*)(a.ws + WS_WOUT); const bf16* Wup_t = (const bf16*)(a.ws + WS_WUP); const bf16* Wdn_t = (const bf16*)(a.ws + WS_WDOWN);
    if constexpr (L < 0) {
        convert_weights(a, 0, 5, lds, gw, NGW, wave, lane);
        prologue_rows(a.in[0], a.in[1], XB, SSM, gw, NGW, lane);
    } else if constexpr (S == 0) {
        pg8::Gemm g{XB, Win_t, M, NINP, D}; PrefetchOrder So; So.init(M, NINP, G, (int)blockIdx.x); So.ssp = SSM; So.cw = nullptr; So.cb = nullptr; So.xl = lds + XL_OFF; So.tid = tid; So.cnt = 0; EpiIn E{Pb, lds + XL_OFF, 0};
        pg8::gemm_phase<EpiIn, PrefetchOrder, PG8_ALIGN, PG8_SP2>(lds, g, So, E, tid);
    } else if constexpr (S == 1) {
        for (int item = blockIdx.x; item < 512; item += G) mixer_a_item(a, L, item, lds, tid, wave, lane);
        xcd_arrive(xb, tid);
        for (int item = blockIdx.x; item < 512; item += G) mixer_gmlp_item(a, L, item, lds, tid, wave, lane);
        xcd_wait(xb, tid);
    } else if constexpr (S == 2) {
        mixer_scan(a, tid);
        xcd_arrive(xb, tid);
    } else if constexpr (S == 3) {
        for (int item = blockIdx.x; item < 512; item += G) mixer_gla_item(a, L, item, lds, tid, wave, lane, xb, item == (int)blockIdx.x);
        xcd_arrive(xb, tid);
        convert_weights(a, L, 2, lds, gw, NGW, wave, lane);
        xcd_wait(xb, tid);
    } else if constexpr (S == 4) {
        pg8::Gemm g{MIX, Wout_t, M, D, D}; pg8::StaticOrder So; So.init(M, D, G, (int)blockIdx.x); EpiRes16<false> E{XB, nullptr, SSF, nullptr, nullptr};
        pg8::gemm_phase<EpiRes16<false>, pg8::StaticOrder, false, PG8_SP2>(lds, g, So, E, tid);
    } else if constexpr (S == 5) {
        pg8::Gemm g{XB, Wup_t, M, NUP, D}; PrefetchOrder So; So.init(M, NUP, G, (int)blockIdx.x); So.ssp = SSF; So.cw = a.in[15] + (size_t)L * 3 * NUP; So.cb = a.in[16] + (size_t)L * NUP; So.xl = lds + XL_OFF; So.tid = tid; So.cnt = 0; EpiUpConv E{ACT, Yb, lds + XL_OFF, 0};
        pg8::gemm_phase<EpiUpConv, PrefetchOrder, PG8_ALIGN, PG8_SP2>(lds, g, So, E, tid);
        { constexpr int NU = (M / 256) * (NUP / 256); const int nfull = NU % G;
          if (L + 1 < DEPTH && (int)blockIdx.x >= nfull) convert_weights(a, L + 1, 1, lds, ((int)blockIdx.x - nfull) * 8 + wave, (G - nfull) * 8, wave, lane); }
        xcd_barrier(xb, tid);
    } else if constexpr (S == 6) {
        conv_fix(a, L, tid);
        if (L + 1 < DEPTH) { xcd_arrive(xb, tid); convert_weights(a, L + 1, 4, lds, gw, NGW, wave, lane); xcd_wait(xb, tid); }
        else xcd_barrier(xb, tid);
    } else if constexpr (S == 7) {
        pg8::Gemm g{ACT, Wdn_t, M, D, FF}; pg8::StaticOrder So; So.init(M, D, G, (int)blockIdx.x); EpiRes16<(L + 1 == DEPTH)> E{XB, a.out, SSM, a.in[18], (unsigned*)a.ws + CW_PCNT};
        pg8::gemm_phase<EpiRes16<(L + 1 == DEPTH)>, pg8::StaticOrder, false, PG8_SP2>(lds, g, So, E, tid);
    } else {
        final_rows(a.out, a.in[18], SSM, gw, NGW, lane);
    }
}
#define SEAM() do { const int t_ = wave_s * 64 + lane_id(); xcd_barrier(xb, t_); } while (0)
#define RUN(L, S) { constexpr int k_ = 1 + NPH_L * (L) + (S); if (ph_lo <= k_ && k_ < ph_hi) { phase_body<L, S>(lds, wave_s, xb); \
    if constexpr ((S) == 0 || (S) == 4 || (S) == 7) { if (k_ + 1 < ph_hi) SEAM(); } } }
#define RUN_LAYER(L) RUN(L, 0) RUN(L, 1) RUN(L, 2) RUN(L, 3) RUN(L, 4) RUN(L, 5) RUN(L, 6) RUN(L, 7)
__global__ void __launch_bounds__(NTHR, 2) mk_fwd(Args a) {
    extern __shared__ __attribute__((aligned(16))) unsigned char lds_raw[];
    LAS unsigned char* lds = (LAS unsigned char*)lds_raw;
    cg::grid_group grid = cg::this_grid();
    const int wave_s = __builtin_amdgcn_readfirstlane((int)(threadIdx.x >> 6));
    volatile LAS unsigned* MISC = (volatile LAS unsigned*)(lds + MISC_OFF);
    if (threadIdx.x < 4) MISC[threadIdx.x] = 0u;
    __syncthreads();
    const int ph_lo = kargs().ph_lo, ph_hi = kargs().ph_hi;
    XcdBarrier xb = xcd_barrier_post((unsigned*)kargs().ws + CW_BAR, MISC, (int)threadIdx.x);
    if (ph_lo <= 0 && 0 < ph_hi) {
        phase_body<-1, 0>(lds, wave_s, xb);
        if (ph_lo < -1) grid.sync();
        if (1 < ph_hi) SEAM();
    }
    RUN_LAYER(0)
    RUN_LAYER(1)
    RUN_LAYER(2)
    RUN_LAYER(3)
}

extern "C" void kernel_launch(void* const* d_in, const int* in_sizes, int n_in, void* d_out, int out_size, void* d_ws, size_t ws_size, hipStream_t stream) {
    static int grid = 0;
    if (grid == 0) {
        if (n_in != 19 || out_size != M * D || ws_size < WS_END) { fprintf(stderr, "kernel_launch: unexpected shapes / workspace (%d inputs, out %d, ws %zu)\n", n_in, out_size, ws_size); grid = -1; return; }
        int dev = 0, cus = 0, per_cu = 0;
        hipGetDevice(&dev); hipDeviceGetAttribute(&cus, hipDeviceAttributeMultiprocessorCount, dev);
        hipFuncSetAttribute((const void*)mk_fwd, hipFuncAttributeMaxDynamicSharedMemorySize, LDS_BYTES);
        hipOccupancyMaxActiveBlocksPerMultiprocessor(&per_cu, (const void*)mk_fwd, NTHR, LDS_BYTES);
        if (per_cu < 1) per_cu = 1;
        grid = cus * per_cu;
        if (grid != 256) { fprintf(stderr, "kernel_launch: built for a 256-workgroup grid (one per CU), got %d\n", grid); grid = -1; return; }
        (void)hipGetLastError();
    }
    if (grid < 0) return;
    if (hipMemsetAsync(d_ws, 0, CTL_ZERO_BYTES, stream) != hipSuccess) return;
    Args a{};
    for (int i = 0; i < 19; ++i) a.in[i] = (const float*)d_in[i];
    a.out = (float*)d_out; a.ws = (unsigned char*)d_ws;
#if MK_SINGLE
    a.ph_lo = 0; a.ph_hi = NPHASE;
    void* args[] = {&a};
    hipError_t e = hipLaunchCooperativeKernel((const void*)mk_fwd, dim3(grid), dim3(NTHR), args, LDS_BYTES, stream);
    if (e != hipSuccess) fprintf(stderr, "cooperative launch failed: %s (grid %d)\n", hipGetErrorString(e), grid);
#else
    for (int ph = 0; ph < NPHASE; ++ph) { a.ph_lo = ph; a.ph_hi = ph + 1; hipLaunchKernelGGL(mk_fwd, dim3(grid), dim3(NTHR), LDS_BYTES, stream, a); }
#endif
}
```

```cpp
#include <hip/hip_runtime.h>
#include <hip/hip_cooperative_groups.h>
#include <cstdio>
#include <cstdint>
namespace pg8 {
#define PG8_LAS __attribute__((address_space(3)))
typedef unsigned short bf16_t;
typedef short bf16x8 __attribute__((ext_vector_type(8)));
typedef float f32x4 __attribute__((ext_vector_type(4)));
typedef unsigned u32x4 __attribute__((ext_vector_type(4)));
constexpr int BM = 256, BK = 64, HALF = 128, HTB = HALF * BK * 2  , STAGE_BYTES = 8 * HTB, NXCD = 8, WGM = 8;

__host__ __device__ __forceinline__ int lds_byte(int r, int c) { const int st = (r >> 4) * 2 + (c >> 5), rr = r & 15, cc = c & 31, ob = rr * 64 + cc * 2; return st * 1024 + (ob ^ (((ob >> 9) & 1) << 5)); }
__host__ __device__ __forceinline__ void stage_rc(int b, int& R, int& C) { const int st = b / 1024, sb = b % 1024, swz = sb ^ (((sb >> 9) & 1) << 5); R = (st >> 1) * 16 + swz / 64; C = (st & 1) * 32 + (swz % 64) / 2; }
__host__ __device__ __forceinline__ int perm32(int rho) { const int n = rho >> 4, i = rho & 15; return 8 * (i >> 2) + 4 * n + (i & 3); }

struct Unit { int pm, pn; };
struct Gemm { const bf16_t* A; const bf16_t* Bt; int M, N, K; };

struct StaticOrder {
    int nM, nN, nwg, G, c;
    __host__ __device__ void init(int M, int N, int G_, int c_) { nM = M / BM; nN = N / BM; nwg = nM * nN; G = G_; c = c_; }
    __host__ __device__ bool next(int i, Unit& u) const {
        const long L = (long)i * G + c; if (L >= nwg) return false;
        int wgid = (int)L; { const int q = nwg / NXCD, r = nwg % NXCD, xcd = wgid % NXCD, off = wgid / NXCD; wgid = (xcd < r ? xcd * (q + 1) : r * (q + 1) + (xcd - r) * q) + off; }
        const int nig = WGM * nN, gid = wgid / nig, fm = gid * WGM, gsz = (nM - fm) < WGM ? (nM - fm) : WGM;
        u.pm = fm + ((wgid % nig) % gsz); u.pn = (wgid % nig) / gsz; return true;
    }
    __device__ __forceinline__ void a_ready(const Unit&) const {}
    __device__ __forceinline__ void done(const Unit&) const {}
};

__device__ __forceinline__ unsigned cvt_pk_bf16(float lo, float hi) { unsigned r; asm volatile("v_cvt_pk_bf16_f32 %0, %1, %2" : "=v"(r) : "v"(lo), "v"(hi)); return r; }
typedef float f32x2 __attribute__((ext_vector_type(2)));
__device__ __forceinline__ f32x2 gelu_pk(f32x2 v) {
    const f32x2 av = __builtin_elementwise_abs(v), d = av * 0.2316418882f + 1.0f;
    f32x2 t; t.x = __builtin_amdgcn_rcpf(d.x); t.y = __builtin_amdgcn_rcpf(d.y);
    f32x2 q = t * 0.5307027145f + (-0.7265760135f); q = q * t + 0.7107068705f; q = q * t + (-0.142248368f); q = q * t + 0.127414796f; q = q * t;
    const f32x2 s = (v * v) * (-0.72134752044f);
    f32x2 e; e.x = __builtin_amdgcn_exp2f(s.x); e.y = __builtin_amdgcn_exp2f(s.y);
    const f32x2 m = v * (q * e), r = v - m;
    f32x2 o; o.x = v.x < 0.f ? m.x : r.x; o.y = v.y < 0.f ? m.y : r.y; return o;
}

template <int ACT  > struct EpiBf16 {
    static constexpr bool PERM = true, AFTER_DRAIN = false; static_assert(ACT == 0 || ACT == 1, "EpiBf16: ACT is 0 (none) or 1 (gelu_pk)");
    bf16_t* O; int ldc; const float* bias; int split_cols; size_t split_stride; float scale0;
    __device__ __forceinline__ void operator()(const f32x4 (&acc)[2][2][4][2], const Unit& u, int wr, int wc, int fr, int fq) const {
        const int row0 = u.pm * BM + wr * 64 + fr; int colt = u.pn * BM; bf16_t* base = O;
        float sc = 1.f; if (split_cols) { const int t = colt / split_cols; base += (size_t)t * split_stride; colt -= t * split_cols; if (t == 0) sc = scale0; }
        const int col0 = colt + wc * 32 + 8 * fq, bcol0 = u.pn * BM + wc * 32 + 8 * fq;
        f32x4 bv[2][2];
#pragma unroll
        for (int bj = 0; bj < 2; ++bj)
#pragma unroll
            for (int n = 0; n < 2; ++n) bv[bj][n] = bias ? *(const f32x4*)(bias + bcol0 + bj * HALF + 4 * n) : (f32x4){0.f, 0.f, 0.f, 0.f};
#pragma unroll
        for (int ai = 0; ai < 2; ++ai)
#pragma unroll
            for (int m = 0; m < 4; ++m) { bf16_t* rowp = base + (size_t)(row0 + ai * HALF + m * 16) * ldc + col0;
#pragma unroll
                for (int bj = 0; bj < 2; ++bj) { f32x4 v0 = acc[ai][bj][m][0] + bv[bj][0], v1 = acc[ai][bj][m][1] + bv[bj][1];
                    if (ACT == 1) { f32x2 a = gelu_pk((f32x2){v0[0], v0[1]}), b = gelu_pk((f32x2){v0[2], v0[3]}), c = gelu_pk((f32x2){v1[0], v1[1]}), d = gelu_pk((f32x2){v1[2], v1[3]});
                        v0 = (f32x4){a.x, a.y, b.x, b.y}; v1 = (f32x4){c.x, c.y, d.x, d.y}; }
                    v0 = v0 * sc; v1 = v1 * sc; u32x4 w; w.x = cvt_pk_bf16(v0[0], v0[1]); w.y = cvt_pk_bf16(v0[2], v0[3]); w.z = cvt_pk_bf16(v1[0], v1[1]); w.w = cvt_pk_bf16(v1[2], v1[3]);
                    *(u32x4*)(rowp + bj * HALF) = w; } }
    }
};
template <class Epi, class Sched, bool ALIGN_EPI = false, bool SP2 = false>
__device__ __forceinline__ void gemm_phase(PG8_LAS unsigned char* lds, const Gemm g, const Sched& S, const Epi& E, const int tid) {
    const int wid = __builtin_amdgcn_readfirstlane(tid >> 6), lane = tid & 63, wr = wid >> 2, wc = wid & 3, fr = lane & 15, fq = lane >> 4;
    const int K = g.K, nt = K / BK;
    unsigned voffA[2], voffB[2];
#pragma unroll
    for (int i = 0; i < 2; ++i) { int R, C; stage_rc(tid * 16 + i * 8192, R, C); const int Rb = Epi::PERM ? ((R & ~31) + perm32(R & 31)) : R;
        const int Ra = Epi::APERM ? ((R & ~63) | ((R & 15) << 2) | ((R >> 4) & 3)) : R;
        voffA[i] = (unsigned)(Ra * K + C) * 2u; voffB[i] = (unsigned)(Rb * K + C) * 2u; }
    const size_t kstep = (size_t)(BK * 2);
    const size_t hstep = (size_t)HALF * K * 2;
    const size_t tstep = 2 * hstep;
    const unsigned ldsw = (unsigned)wid * 1024u;
    const int aoff = lds_byte(wr * 64 + fr, fq * 8), boff = lds_byte(wc * 32 + fr, fq * 8);
#define PG8_SA(b, h) (((b) * 2 + (h)) * HTB)
#define PG8_SB(b, h) ((4 + (b) * 2 + (h)) * HTB)
#define PG8_STAGE(bufoff, gbase, voff) do { _Pragma("unroll") for (int _i = 0; _i < 2; ++_i) \
        __builtin_amdgcn_global_load_lds((const unsigned*)((const char*)(gbase) + (voff)[_i]), (PG8_LAS unsigned*)(lds + (bufoff) + ldsw + _i * 8192), 16, 0, 0); } while (0)
#define PG8_LDA(dst, b, h) do { _Pragma("unroll") for (int m = 0; m < 4; ++m) _Pragma("unroll") for (int k = 0; k < 2; ++k) dst[m][k] = *(const PG8_LAS bf16x8*)(lds + PG8_SA(b, h) + aoff + m * 2048 + k * 1024); } while (0)
#define PG8_LDB(dst, b, h) do { _Pragma("unroll") for (int n = 0; n < 2; ++n) _Pragma("unroll") for (int k = 0; k < 2; ++k) dst[n][k] = *(const PG8_LAS bf16x8*)(lds + PG8_SB(b, h) + boff + n * 2048 + k * 1024); } while (0)
#define PG8_MMA(ai, bj, At, Bt) do { __builtin_amdgcn_s_setprio(1); _Pragma("unroll") for (int m = 0; m < 4; ++m) _Pragma("unroll") for (int n = 0; n < 2; ++n) _Pragma("unroll") for (int k = 0; k < 2; ++k) \
        acc[ai][bj][m][n] = __builtin_amdgcn_mfma_f32_16x16x32_bf16(Bt[n][k], At[m][k], acc[ai][bj][m][n], 0, 0, 0); __builtin_amdgcn_s_setprio(0); } while (0)
#define PG8_WAIT_V(n) asm volatile("s_waitcnt vmcnt(" #n ")" ::: "memory")
#define PG8_WAIT_L(n) asm volatile("s_waitcnt lgkmcnt(" #n ")" ::: "memory")
#define PG8_BAR __builtin_amdgcn_s_barrier()
#define PG8_SCHED __builtin_amdgcn_sched_barrier(0)
    Unit cur, nxt; int ui = 0;
    if (!S.next(0, cur)) return;
    f32x4 acc[2][2][4][2];
#pragma unroll
    for (int a = 0; a < 2; ++a)
#pragma unroll
        for (int b = 0; b < 2; ++b)
#pragma unroll
            for (int m = 0; m < 4; ++m)
#pragma unroll
                for (int n = 0; n < 2; ++n) acc[a][b][m][n] = (f32x4){0.f, 0.f, 0.f, 0.f};
    bf16x8 At[4][2], B0[2][2], B1[2][2];
    const char* cA = (const char*)g.A + (size_t)cur.pm * tstep; const char* cB = (const char*)g.Bt + (size_t)cur.pn * tstep;
    S.a_ready(cur);
    if constexpr (SP2) {
        PG8_STAGE(PG8_SB(0, 0), cB, voffB); PG8_STAGE(PG8_SB(0, 1), cB + hstep, voffB); PG8_STAGE(PG8_SA(0, 0), cA, voffA); PG8_STAGE(PG8_SA(0, 1), cA + hstep, voffA);
        if (wr == 1) PG8_BAR;
        PG8_WAIT_V(2); PG8_BAR;
        PG8_STAGE(PG8_SB(1, 0), cB + kstep, voffB); PG8_STAGE(PG8_SA(1, 0), cA + kstep, voffA); PG8_STAGE(PG8_SB(1, 1), cB + hstep + kstep, voffB);
        PG8_WAIT_V(6); PG8_BAR;
    } else {
        PG8_STAGE(PG8_SB(0, 0), cB, voffB); PG8_STAGE(PG8_SA(0, 0), cA, voffA); PG8_STAGE(PG8_SB(0, 1), cB + hstep, voffB); PG8_STAGE(PG8_SA(0, 1), cA + hstep, voffA);
        if (wr == 1) PG8_BAR;
        PG8_WAIT_V(4); PG8_BAR;
        PG8_STAGE(PG8_SB(1, 0), cB + kstep, voffB); PG8_STAGE(PG8_SA(1, 0), cA + kstep, voffA); PG8_STAGE(PG8_SB(1, 1), cB + hstep + kstep, voffB);
        PG8_WAIT_V(6); PG8_BAR;
    }
    for (;;) {
        const bool has_next = S.next(ui + 1, nxt);
        const char* nA = has_next ? (const char*)g.A + (size_t)nxt.pm * tstep : cA; const char* nB = has_next ? (const char*)g.Bt + (size_t)nxt.pn * tstep : cB;
        for (int t = 0; t < nt; t += 2) {
            const bool last = (t == nt - 2);
            const char* a1 = cA + (size_t)(t + 1) * kstep;
            const char* a2 = last ? nA : cA + (size_t)(t + 2) * kstep; const char* b2 = last ? nB : cB + (size_t)(t + 2) * kstep;
            const char* a3 = a2 + kstep; const char* b3 = b2 + kstep;
            if (last && has_next) S.a_ready(nxt);
            if constexpr (SP2) {
            PG8_LDB(B0, 0, 0); PG8_LDB(B1, 0, 1); PG8_SCHED; PG8_LDA(At, 0, 0); PG8_STAGE(PG8_SA(1, 1), a1 + hstep, voffA);
            PG8_WAIT_V(8); PG8_WAIT_L(0); PG8_BAR; PG8_MMA(0, 0, At, B0); PG8_MMA(0, 1, At, B1); PG8_BAR; PG8_SCHED;
            PG8_LDA(At, 0, 1); PG8_STAGE(PG8_SB(0, 0), b2, voffB); PG8_STAGE(PG8_SB(0, 1), b2 + hstep, voffB); PG8_STAGE(PG8_SA(0, 0), a2, voffA);
            PG8_WAIT_V(8); PG8_WAIT_L(0); PG8_BAR; PG8_MMA(1, 0, At, B0); PG8_MMA(1, 1, At, B1); PG8_BAR; PG8_SCHED;
            PG8_LDB(B0, 1, 0); PG8_LDB(B1, 1, 1); PG8_SCHED; PG8_LDA(At, 1, 0); PG8_STAGE(PG8_SA(0, 1), a2 + hstep, voffA);
            PG8_WAIT_V(8); PG8_WAIT_L(0); PG8_BAR; PG8_MMA(0, 0, At, B0); PG8_MMA(0, 1, At, B1); PG8_BAR; PG8_SCHED;
            PG8_LDA(At, 1, 1); PG8_STAGE(PG8_SB(1, 0), b3, voffB); PG8_STAGE(PG8_SB(1, 1), b3 + hstep, voffB); PG8_STAGE(PG8_SA(1, 0), a3, voffA);
            PG8_WAIT_V(8); PG8_WAIT_L(0); PG8_BAR; PG8_MMA(1, 0, At, B0); PG8_MMA(1, 1, At, B1); PG8_BAR; PG8_SCHED;
            } else {
            PG8_LDB(B0, 0, 0); PG8_SCHED; PG8_LDA(At, 0, 0); PG8_STAGE(PG8_SA(1, 1), a1 + hstep, voffA);
            PG8_WAIT_L(8); PG8_BAR; PG8_WAIT_L(0); PG8_MMA(0, 0, At, B0); PG8_BAR; PG8_SCHED;
            PG8_LDB(B1, 0, 1); PG8_STAGE(PG8_SB(0, 0), b2, voffB);
            PG8_BAR; PG8_WAIT_L(0); PG8_MMA(0, 1, At, B1); PG8_BAR;
            PG8_LDA(At, 0, 1); PG8_STAGE(PG8_SA(0, 0), a2, voffA);
            PG8_BAR; PG8_WAIT_L(0); PG8_MMA(1, 0, At, B0); PG8_BAR; PG8_SCHED;
            PG8_STAGE(PG8_SB(0, 1), b2 + hstep, voffB);
            PG8_WAIT_V(6); PG8_BAR; PG8_MMA(1, 1, At, B1); PG8_BAR;
            PG8_LDB(B0, 1, 0); PG8_SCHED; PG8_LDA(At, 1, 0); PG8_STAGE(PG8_SA(0, 1), a2 + hstep, voffA);
            PG8_WAIT_L(8); PG8_BAR; PG8_WAIT_L(0); PG8_MMA(0, 0, At, B0); PG8_BAR; PG8_SCHED;
            PG8_LDB(B1, 1, 1); PG8_STAGE(PG8_SB(1, 0), b3, voffB);
            PG8_BAR; PG8_WAIT_L(0); PG8_MMA(0, 1, At, B1); PG8_BAR;
            PG8_LDA(At, 1, 1); PG8_STAGE(PG8_SA(1, 0), a3, voffA);
            PG8_BAR; PG8_WAIT_L(0); PG8_MMA(1, 0, At, B0); PG8_BAR; PG8_SCHED;
            PG8_STAGE(PG8_SB(1, 1), b3 + hstep, voffB);
            PG8_WAIT_V(6); PG8_BAR; PG8_MMA(1, 1, At, B1); PG8_BAR;
            }
        }
        if constexpr (ALIGN_EPI) { if (wr == 0) PG8_BAR; }
        if constexpr (!Epi::AFTER_DRAIN) { E(acc, cur, wr, wc, fr, fq); S.done(cur); }
        if (!has_next) break;
#pragma unroll
        for (int a = 0; a < 2; ++a)
#pragma unroll
            for (int b = 0; b < 2; ++b)
#pragma unroll
                for (int m = 0; m < 4; ++m)
#pragma unroll
                    for (int n = 0; n < 2; ++n) acc[a][b][m][n] = (f32x4){0.f, 0.f, 0.f, 0.f};
        cur = nxt; cA = nA; cB = nB; ++ui;
        if constexpr (ALIGN_EPI) { if (wr == 1) PG8_BAR; }
    }
    PG8_WAIT_V(0);
    if constexpr (!ALIGN_EPI) { if (wr == 0) PG8_BAR; }
    PG8_BAR;
    if constexpr (Epi::AFTER_DRAIN) { E.fused(acc, cur, wr, wc, fr, fq, lds, wid, lane); S.done(cur); }
#undef PG8_SA
#undef PG8_SB
#undef PG8_STAGE
#undef PG8_LDA
#undef PG8_LDB
#undef PG8_MMA
#undef PG8_WAIT_V
#undef PG8_WAIT_L
#undef PG8_BAR
#undef PG8_SCHED
}
}
#define LAS __attribute__((address_space(3)))
#define XB_TMO      128
#define XB_XCNT(j)  (256  + 64 * (j))
#define XB_XSUB(j)  (1280 + 64 * (j))
#define XB_XGEN(j)  (2304 + 64 * (j))
#define XB_TOP      3328
#define XB_TOPGEN   3392
#define XCD_BAR_WORDS 3456
#define XB_SPIN_CAP (1u << 18)

__device__ __forceinline__ unsigned xb_ld(unsigned* p)              { return __hip_atomic_load(p, __ATOMIC_RELAXED, __HIP_MEMORY_SCOPE_AGENT); }
__device__ __forceinline__ unsigned xb_add(unsigned* p, unsigned v) { return __hip_atomic_fetch_add(p, v, __ATOMIC_RELAXED, __HIP_MEMORY_SCOPE_AGENT); }
__device__ __forceinline__ unsigned xb_xcc_id() { return (unsigned)__builtin_amdgcn_s_getreg((3 << 11) | 20) & 0xFu; }
#define XB_SPIN(cond, bar) do { unsigned _sp = 0; while (cond) { __builtin_amdgcn_s_sleep(1); \
    if ((++_sp & 255u) == 0u) { if (xb_ld(&(bar)[XB_TMO])) break; if (_sp > XB_SPIN_CAP) { atomicAdd(&(bar)[XB_TMO], 1u); break; } } } } while (0)

struct XcdBarrier {
    unsigned* bar; unsigned x;
    volatile LAS unsigned* st;
};

__device__ __forceinline__ XcdBarrier xcd_barrier_post(unsigned* bar, volatile LAS unsigned* st, const int tid) {
    XcdBarrier b; b.bar = bar; b.x = xb_xcc_id(); b.st = st;
    if (tid == 0) (void)xb_add(&bar[XB_XCNT(b.x)], 1u);
    return b;
}
__device__ __forceinline__ void xcd_barrier_complete(unsigned* bar, unsigned x, unsigned& nloc, unsigned& nx) {
    const unsigned G = gridDim.x * gridDim.y * gridDim.z;
    unsigned sum, cnt, mine, sp = 0u;
    for (;;) {
        sum = 0u; cnt = 0u; mine = 0u;
#pragma unroll
        for (unsigned j = 0; j < 16; ++j) { const unsigned c = xb_ld(&bar[XB_XCNT(j)]); sum += c; cnt += (c > 0u) ? 1u : 0u; mine = (j == x) ? c : mine; }
        if (sum == G) break;
        __builtin_amdgcn_s_sleep(1);
        if ((++sp & 255u) == 0u) { if (xb_ld(&bar[XB_TMO])) break; if (sp > XB_SPIN_CAP) { atomicAdd(&bar[XB_TMO], 1u); break; } }
    }
    nloc = mine > 0u ? mine : 1u; nx = cnt > 0u ? cnt : 1u;
}

__device__ __forceinline__ void xcd_barrier(const XcdBarrier& b, const int tid) {
    asm volatile("s_waitcnt vmcnt(0)" ::: "memory");
    __syncthreads();
    if (tid == 0) {
        unsigned* bar = b.bar;
        __builtin_amdgcn_s_waitcnt(0);
        unsigned nloc = b.st[0], nx = b.st[1];
        if (nloc == 0u) { xcd_barrier_complete(bar, b.x, nloc, nx); b.st[0] = nloc; b.st[1] = nx; }
        const unsigned old = xb_add(&bar[XB_XSUB(b.x)], 1u);
        const unsigned gen = old / nloc;
        if (old + 1u == (gen + 1u) * nloc) {
            __builtin_amdgcn_fence(__ATOMIC_RELEASE, "agent");
            asm volatile("s_waitcnt vmcnt(0)" ::: "memory");
            const unsigned og = xb_add(&bar[XB_TOP], 1u);
            const unsigned tg = og / nx;
            if (og + 1u == (tg + 1u) * nx) xb_add(&bar[XB_TOPGEN], 1u);
            else XB_SPIN(xb_ld(&bar[XB_TOPGEN]) == tg, bar);
            __builtin_amdgcn_fence(__ATOMIC_ACQUIRE, "agent");
            xb_add(&bar[XB_XGEN(b.x)], 1u);
            asm volatile("s_waitcnt vmcnt(0)" ::: "memory");
        } else {
            XB_SPIN(xb_ld(&bar[XB_XGEN(b.x)]) == gen, bar);
            __builtin_amdgcn_fence(__ATOMIC_ACQUIRE, "agent");
            asm volatile("s_waitcnt vmcnt(0)" ::: "memory");
        }
    }
    __syncthreads();
}
#ifndef PG8_SP2
#define PG8_SP2 true
#endif
#ifndef PG8_ALIGN
#define PG8_ALIGN true
#endif
#ifndef NLAYERS
#define NLAYERS 4
#endif
#ifndef MK_SINGLE
#define MK_SINGLE 1
#endif
namespace cg = cooperative_groups;
#define LAS __attribute__((address_space(3)))
typedef unsigned short bf16;
typedef float f32x4 __attribute__((ext_vector_type(4)));
typedef float f32x2 __attribute__((ext_vector_type(2)));
typedef short bf16x8 __attribute__((ext_vector_type(8)));
typedef unsigned u32x4 __attribute__((ext_vector_type(4)));
typedef unsigned u32x2 __attribute__((ext_vector_type(2)));

__device__ __forceinline__ void xcd_arrive(const XcdBarrier& b, const int tid) {
    asm volatile("s_waitcnt vmcnt(0)" ::: "memory");
    __syncthreads();
    if (tid == 0) {
        unsigned* bar = b.bar;
        __builtin_amdgcn_s_waitcnt(0);
        unsigned nloc = b.st[0], nx = b.st[1];
        if (nloc == 0u) { xcd_barrier_complete(bar, b.x, nloc, nx); b.st[0] = nloc; b.st[1] = nx; }
        const unsigned old = xb_add(&bar[XB_XSUB(b.x)], 1u);
        const unsigned gen = old / nloc;
        b.st[2] = gen;
        if (old + 1u == (gen + 1u) * nloc) {
            __builtin_amdgcn_fence(__ATOMIC_RELEASE, "agent");
            asm volatile("s_waitcnt vmcnt(0)" ::: "memory");
            (void)xb_add(&bar[XB_XGEN(b.x)], 1u);
            asm volatile("s_waitcnt vmcnt(0)" ::: "memory");
            const unsigned og = xb_add(&bar[XB_TOP], 1u);
            const unsigned tg = og / nx;
            if (og + 1u == (tg + 1u) * nx) xb_add(&bar[XB_TOPGEN], 1u);
        }
    }
    __syncthreads();
}
__device__ __forceinline__ void xcd_wait(const XcdBarrier& b, const int tid) {
    __syncthreads();
    if (tid == 0) {
        unsigned* bar = b.bar;
        const unsigned gen = b.st[2];
        XB_SPIN(xb_ld(&bar[XB_TOPGEN]) <= gen, bar);
        __builtin_amdgcn_fence(__ATOMIC_ACQUIRE, "agent");
        asm volatile("s_waitcnt vmcnt(0)" ::: "memory");
    }
    __syncthreads();
}
constexpr int NTHR = 512;
constexpr int BATCH = 2, SEQ = 8192, D = 1024, M = BATCH * SEQ, DEPTH = 4;
constexpr int NIN = 2592, NINP = 2816, FF = 2816, NUP = 5632;
constexpr float EPS = 1e-6f;
constexpr int NPHASE = 1 + 8 * DEPTH;
constexpr size_t MiB = 1u << 20;
constexpr size_t WS_WIN = 2 * MiB, WS_WOUT = 8 * MiB, WS_WUP = 10 * MiB, WS_WDOWN = 21 * MiB;
constexpr size_t WS_R1 = 28 * MiB;
constexpr size_t WS_P = WS_R1, WS_MIX = WS_R1 + 88 * MiB, WS_DS = WS_R1 + 120 * MiB, WS_ST = WS_R1 + 152 * MiB, WS_DEC = WS_R1 + 168 * MiB;
constexpr size_t WS_R2 = 204 * MiB;
constexpr size_t WS_CUM = WS_R2;
constexpr size_t WS_XB = 292 * MiB;
constexpr size_t WS_END = 324 * MiB;
constexpr size_t WS_SSM = 1024 * 1024, WS_SSF = WS_SSM + 256 * 1024;
constexpr size_t WS_XN2 = WS_MIX;
constexpr int LDS_BYTES = 131072 + 16384 + 64, MISC_OFF = LDS_BYTES - 64, XL_OFF = 131072;
constexpr int CW_PCNT = 8192;
constexpr int CW_BAR = 4096;
constexpr size_t CTL_ZERO_BYTES = 65536;
constexpr int LDT = 136, LDK = 72;
constexpr int MB0 = 0, MB1 = 34816, MB2 = 69632, MB3 = 104448;
constexpr int RBUF_OFF = MB1, TOT_OFF = MB1 + 16384;

struct Args { const float* in[19]; float* out; unsigned char* ws; int ph_lo, ph_hi; };

__device__ __forceinline__ unsigned pk2(float lo, float hi) { return pg8::cvt_pk_bf16(lo, hi); }
__device__ __forceinline__ float bf_lo(unsigned u) { return __uint_as_float(u << 16); }
__device__ __forceinline__ float bf_hi(unsigned u) { return __uint_as_float(u & 0xffff0000u); }
__device__ __forceinline__ unsigned f2bf(float f) { unsigned u = __float_as_uint(f); return (u + 0x7fffu + ((u >> 16) & 1u)) >> 16; }
__device__ __forceinline__ float wave_sum(float v) {
#pragma unroll
    for (int o = 1; o < 64; o <<= 1) v += __shfl_xor(v, o);
    return v;
}
template <int CTRL, int ROWMASK, bool BC> __device__ __forceinline__ float dpp_add(float v) { return v + __int_as_float(__builtin_amdgcn_update_dpp(0, __float_as_int(v), CTRL, ROWMASK, 0xf, BC)); }
__device__ __forceinline__ float wave_sum_dpp(float v) {
    v = dpp_add<0x111, 0xf, true>(v); v = dpp_add<0x112, 0xf, true>(v); v = dpp_add<0x114, 0xf, true>(v); v = dpp_add<0x118, 0xf, true>(v);
    v = dpp_add<0x142, 0xa, false>(v); v = dpp_add<0x143, 0xc, false>(v);
    return __int_as_float(__builtin_amdgcn_readlane(__float_as_int(v), 63));
}
__device__ __forceinline__ float silu_f(float x) { return x * __frcp_rn(1.f + __expf(-x)); }
__device__ __forceinline__ f32x4 silu4(f32x4 x) {
    const f32x4 a = x * (-1.44269504089f);
    f32x4 e; e[0] = __builtin_amdgcn_exp2f(a[0]); e[1] = __builtin_amdgcn_exp2f(a[1]); e[2] = __builtin_amdgcn_exp2f(a[2]); e[3] = __builtin_amdgcn_exp2f(a[3]);
    const f32x4 d = e + 1.f;
    f32x4 r; r[0] = __builtin_amdgcn_rcpf(d[0]); r[1] = __builtin_amdgcn_rcpf(d[1]); r[2] = __builtin_amdgcn_rcpf(d[2]); r[3] = __builtin_amdgcn_rcpf(d[3]);
    return x * r;
}
__device__ __forceinline__ float logsig_f(float x) { return fminf(x, 0.f) - __logf(1.f + __expf(-fabsf(x))); }

__device__ __forceinline__ float lds_rstd(const LAS unsigned char* slot, int rowlocal) { const f32x4 p = *(const LAS f32x4*)(slot + 4096 + rowlocal * 16); return rsqrtf(((p[0] + p[1]) + (p[2] + p[3])) * (1.f / D) + EPS); }
__device__ __forceinline__ float row_rstd(const float* ssp, int row) { const f32x4 p = *(const f32x4*)(ssp + (size_t)row * 4); return rsqrtf(((p[0] + p[1]) + (p[2] + p[3])) * (1.f / D) + EPS); }
struct EpiIn {
    static constexpr bool PERM = true, AFTER_DRAIN = false, APERM = false;
    bf16* O; LAS unsigned char* xl; mutable int cnt;
    __device__ __forceinline__ void operator()(const f32x4 (&acc)[2][2][4][2], const pg8::Unit& u, int wr, int wc, int fr, int fq) const {
        const int row0 = u.pm * 256 + wr * 64 + fr, col0 = u.pn * 256 + wc * 32 + 8 * fq;
        const LAS unsigned char* slot = xl + (cnt & 1) * 8192; ++cnt;
        if (u.pn * 256 + wc * 32 >= NIN) return;
        const bool act = u.pn < 4; const float sc = (u.pn == 4) ? 0.125f : 1.f;
        float rsa[2][4];
#pragma unroll
        for (int ai = 0; ai < 2; ++ai)
#pragma unroll
            for (int m = 0; m < 4; ++m) rsa[ai][m] = lds_rstd(slot, ai * 128 + wr * 64 + m * 16 + fr);
#pragma unroll
        for (int ai = 0; ai < 2; ++ai)
#pragma unroll
            for (int m = 0; m < 4; ++m) { const int row = row0 + ai * 128 + m * 16; bf16* rowp = O + (size_t)row * NINP + col0;
                const float rs = rsa[ai][m];
#pragma unroll
                for (int bj = 0; bj < 2; ++bj) { f32x4 v0 = acc[ai][bj][m][0] * rs, v1 = acc[ai][bj][m][1] * rs;
                    if (act) { f32x2 a = pg8::gelu_pk((f32x2){v0[0], v0[1]}), b = pg8::gelu_pk((f32x2){v0[2], v0[3]}), c = pg8::gelu_pk((f32x2){v1[0], v1[1]}), d = pg8::gelu_pk((f32x2){v1[2], v1[3]});
                        v0 = (f32x4){a.x, a.y, b.x, b.y}; v1 = (f32x4){c.x, c.y, d.x, d.y}; }
                    v0 = v0 * sc; v1 = v1 * sc; u32x4 w; w.x = pk2(v0[0], v0[1]); w.y = pk2(v0[2], v0[3]); w.z = pk2(v1[0], v1[1]); w.w = pk2(v1[2], v1[3]);
                    *(u32x4*)(rowp + bj * 128) = w; } }
    }
};
struct EpiUp {
    static constexpr bool PERM = true, AFTER_DRAIN = false;
    bf16* O; const float* ss;
    __device__ __forceinline__ void operator()(const f32x4 (&acc)[2][2][4][2], const pg8::Unit& u, int wr, int wc, int fr, int fq) const {
        const int row0 = u.pm * 256 + wr * 64 + fr, col0 = u.pn * 256 + wc * 32 + 8 * fq;
#pragma unroll
        for (int ai = 0; ai < 2; ++ai)
#pragma unroll
            for (int m = 0; m < 4; ++m) { const int row = row0 + ai * 128 + m * 16; bf16* rowp = O + (size_t)row * NUP + col0;
                const float rs = row_rstd(ss, row);
#pragma unroll
                for (int bj = 0; bj < 2; ++bj) { const f32x4 v0 = acc[ai][bj][m][0] * rs, v1 = acc[ai][bj][m][1] * rs;
                    u32x4 w; w.x = pk2(v0[0], v0[1]); w.y = pk2(v0[2], v0[3]); w.z = pk2(v1[0], v1[1]); w.w = pk2(v1[2], v1[3]);
                    *(u32x4*)(rowp + bj * 128) = w; } }
    }
};
template <bool LAST>
struct EpiRes16 {
    static constexpr bool PERM = true, AFTER_DRAIN = true, APERM = false;
    bf16* xb; float* out; float* ssp; const float* gfin; unsigned* pcnt;
    __device__ __forceinline__ void fused(f32x4 (&acc)[2][2][4][2], const pg8::Unit& u, int wr, int wc, int fr, int fq, PG8_LAS unsigned char* lds, int wid, int lane) const {
        const int row0 = u.pm * 256 + wr * 64 + fr, col0 = u.pn * 256 + wc * 32 + 8 * fq;
        PG8_LAS float* part = (PG8_LAS float*)lds;
        PG8_LAS float* rtab = (PG8_LAS float*)(lds + 4096);
        u32x4 xva[2][4][2];
#pragma unroll
        for (int ai = 0; ai < 2; ++ai)
#pragma unroll
            for (int m = 0; m < 4; ++m)
#pragma unroll
                for (int bj = 0; bj < 2; ++bj) xva[ai][m][bj] = *(const u32x4*)(xb + (size_t)(row0 + ai * 128 + m * 16) * D + col0 + bj * 128);
        f32x4 gq[2][2];
        if (LAST) {
#pragma unroll
            for (int bj = 0; bj < 2; ++bj) { gq[bj][0] = *(const f32x4*)(gfin + col0 + bj * 128); gq[bj][1] = *(const f32x4*)(gfin + col0 + bj * 128 + 4); } }
#pragma unroll
        for (int ai = 0; ai < 2; ++ai)
#pragma unroll
            for (int m = 0; m < 4; ++m) { const int row = row0 + ai * 128 + m * 16; const size_t off = (size_t)row * D + col0; float sq = 0.f;
#pragma unroll
                for (int bj = 0; bj < 2; ++bj) { const u32x4 xv = xva[ai][m][bj];
                    const f32x4 x0 = (f32x4){bf_lo(xv.x), bf_hi(xv.x), bf_lo(xv.y), bf_hi(xv.y)} + acc[ai][bj][m][0], x1 = (f32x4){bf_lo(xv.z), bf_hi(xv.z), bf_lo(xv.w), bf_hi(xv.w)} + acc[ai][bj][m][1];
                    sq += ((x0[0] * x0[0] + x0[1] * x0[1]) + (x0[2] * x0[2] + x0[3] * x0[3])) + ((x1[0] * x1[0] + x1[1] * x1[1]) + (x1[2] * x1[2] + x1[3] * x1[3]));
                    if (LAST) { acc[ai][bj][m][0] = x0; acc[ai][bj][m][1] = x1; }
                    else *(u32x4*)(xb + off + bj * 128) = (u32x4){pk2(x0[0], x0[1]), pk2(x0[2], x0[3]), pk2(x1[0], x1[1]), pk2(x1[2], x1[3])}; }
                sq += __shfl_xor(sq, 16); sq += __shfl_xor(sq, 32);
                if (fq == 0) part[(ai * 128 + wr * 64 + m * 16 + fr) * 4 + wc] = sq; }
        asm volatile("s_waitcnt lgkmcnt(0)" ::: "memory"); __builtin_amdgcn_s_barrier(); asm volatile("" ::: "memory");
        const int t = wid * 64 + lane;
        float own = 0.f;
        if (t < 256) { const f32x4 p = *(const PG8_LAS f32x4*)(part + t * 4); own = (p[0] + p[1]) + (p[2] + p[3]); }
        if (!LAST) { if (t < 256) ssp[(size_t)(u.pm * 256 + t) * 4 + u.pn] = own; }
        else {
            if (t < 256) __hip_atomic_store(ssp + (size_t)(u.pm * 256 + t) * 4 + u.pn, own, __ATOMIC_RELAXED, __HIP_MEMORY_SCOPE_AGENT);
            asm volatile("s_waitcnt vmcnt(0)" ::: "memory");
            if (wid < 4 && lane == 0) __hip_atomic_fetch_add(pcnt + 64 * u.pm, 1u, __ATOMIC_RELAXED, __HIP_MEMORY_SCOPE_AGENT);
            if (wid == 0) {
                for (unsigned sp = 0; sp < (1u << 20); ++sp) {
                    if ((unsigned)__builtin_amdgcn_readfirstlane((int)__hip_atomic_load(pcnt + 64 * u.pm, __ATOMIC_RELAXED, __HIP_MEMORY_SCOPE_AGENT)) >= 16u) break;
                    __builtin_amdgcn_s_sleep(2);
                }
                __builtin_amdgcn_fence(__ATOMIC_ACQUIRE, "agent");
            }
            asm volatile("s_waitcnt vmcnt(0) lgkmcnt(0)" ::: "memory"); __builtin_amdgcn_s_barrier(); asm volatile("" ::: "memory");
            if (t < 256) { const float* sp4 = ssp + (size_t)(u.pm * 256 + t) * 4; float q4[4];
#pragma unroll
                for (int k = 0; k < 4; ++k) q4[k] = __hip_atomic_load(sp4 + k, __ATOMIC_RELAXED, __HIP_MEMORY_SCOPE_AGENT);
                rtab[t] = rsqrtf(((q4[0] + q4[1]) + (q4[2] + q4[3])) * (1.f / D) + EPS); }
            asm volatile("s_waitcnt vmcnt(0) lgkmcnt(0)" ::: "memory"); __builtin_amdgcn_s_barrier(); asm volatile("" ::: "memory");
#pragma unroll
            for (int ai = 0; ai < 2; ++ai)
#pragma unroll
                for (int m = 0; m < 4; ++m) { const float rs = rtab[ai * 128 + wr * 64 + m * 16 + fr]; const size_t off = (size_t)(row0 + ai * 128 + m * 16) * D + col0;
#pragma unroll
                    for (int bj = 0; bj < 2; ++bj) { *(f32x4*)(out + off + bj * 128) = acc[ai][bj][m][0] * rs * gq[bj][0]; *(f32x4*)(out + off + bj * 128 + 4) = acc[ai][bj][m][1] * rs * gq[bj][1]; } }
        }
    }
};

struct PrefetchOrder : pg8::StaticOrder {
    const float* ssp; const float* cw; const float* cb; LAS unsigned char* xl; int tid; mutable int cnt;
    __device__ __forceinline__ void a_ready(const pg8::Unit& u) const {
        LAS unsigned char* dst = xl + (cnt & 1) * 8192; ++cnt;
        const int wv = __builtin_amdgcn_readfirstlane(tid >> 6), ln = tid & 63;
        if (wv < 4) {
            if (cw) { const int run = 2 * wv + (ln >> 5), k = run & 3, half = run >> 2;
                const float* src = (k < 3 ? cw + (size_t)k * NUP : cb) + half * FF + u.pn * 128 + (ln & 31) * 4;
                __builtin_amdgcn_global_load_lds((const unsigned*)src, (LAS unsigned*)(dst + wv * 1024), 16, 0, 0); }
        } else {
            const float* src = ssp + (size_t)(u.pm * 256 + (wv - 4) * 64 + ln) * 4;
            __builtin_amdgcn_global_load_lds((const unsigned*)src, (LAS unsigned*)(dst + 4096 + (wv - 4) * 1024), 16, 0, 0);
        }
    }
};
constexpr int DPP_SHR1 = 0x111, DPP_SHL1 = 0x101, DPP_ROR1 = 0x121, DPP_ROR15 = 0x12F;
template <int CTRL> __device__ __forceinline__ float dpp0(float v) { return __int_as_float(__builtin_amdgcn_update_dpp(0, __float_as_int(v), CTRL, 0xf, 0xf, true)); }
__device__ __forceinline__ float dpp_prev(float cur, float grp_below) {
    const int t = __builtin_amdgcn_update_dpp(0, __float_as_int(grp_below), DPP_ROR1, 0xf, 0xf, false);
    return __int_as_float(__builtin_amdgcn_update_dpp(t, __float_as_int(cur), DPP_SHR1, 0xf, 0xf, false)); }
__device__ __forceinline__ float dpp_next(float cur, float grp_above) {
    const int t = __builtin_amdgcn_update_dpp(0, __float_as_int(grp_above), DPP_ROR15, 0xf, 0xf, false);
    return __int_as_float(__builtin_amdgcn_update_dpp(t, __float_as_int(cur), DPP_SHL1, 0xf, 0xf, false)); }
struct EpiUpConv {
    static constexpr bool PERM = false, AFTER_DRAIN = false, APERM = true;
    bf16* ACT; bf16* YB; LAS unsigned char* xl; mutable int cnt;
    __device__ __forceinline__ void operator()(const f32x4 (&acc)[2][2][4][2], const pg8::Unit& u, int wr, int wc, int fr, int fq) const {
        const int cg0 = wc * 32 + 4 * fq, jg0 = u.pn * 128 + cg0;
        const LAS unsigned char* slot = xl + (cnt & 1) * 8192; ++cnt;
        float rs[2][4];
#pragma unroll
        for (int ai = 0; ai < 2; ++ai)
#pragma unroll
            for (int m = 0; m < 4; ++m) rs[ai][m] = lds_rstd(slot, ai * 128 + wr * 64 + 4 * fr + m);
#pragma unroll
        for (int n = 0; n < 2; ++n) {
            const int jg = jg0 + 16 * n;
            const LAS unsigned char* wl = slot + (cg0 + 16 * n) * 4;
            const f32x4 wg0 = *(const LAS f32x4*)(wl), wg1 = *(const LAS f32x4*)(wl + 512), wg2 = *(const LAS f32x4*)(wl + 1024), bg = *(const LAS f32x4*)(wl + 1536);
            const f32x4 wv0 = *(const LAS f32x4*)(wl + 2048), wv1 = *(const LAS f32x4*)(wl + 2560), wv2 = *(const LAS f32x4*)(wl + 3072), bv = *(const LAS f32x4*)(wl + 3584);
#pragma unroll
            for (int ai = 0; ai < 2; ++ai) {
                f32x4 Gv[4], Vv[4];
#pragma unroll
                for (int m = 0; m < 4; ++m) { Gv[m] = acc[ai][0][m][n] * rs[ai][m]; Vv[m] = acc[ai][1][m][n] * rs[ai][m]; }
                const int blk = u.pm * 4 + ai * 2 + wr;
                bf16* ybp = YB + (size_t)(blk * 4) * NUP + u.pn * 256 + cg0 + 16 * n;
                if (fr == 0) {
#pragma unroll
                    for (int q = 0; q < 2; ++q) { bf16* p = ybp + (size_t)q * NUP; *(u32x2*)p = (u32x2){pk2(Gv[q][0], Gv[q][1]), pk2(Gv[q][2], Gv[q][3])}; *(u32x2*)(p + 128) = (u32x2){pk2(Vv[q][0], Vv[q][1]), pk2(Vv[q][2], Vv[q][3])}; } }
                if (fr == 15) {
#pragma unroll
                    for (int q = 2; q < 4; ++q) { bf16* p = ybp + (size_t)q * NUP; *(u32x2*)p = (u32x2){pk2(Gv[q][0], Gv[q][1]), pk2(Gv[q][2], Gv[q][3])}; *(u32x2*)(p + 128) = (u32x2){pk2(Vv[q][0], Vv[q][1]), pk2(Vv[q][2], Vv[q][3])}; } }
                f32x4 gpre, gnxt, vpre, vnxt;
#pragma unroll
                for (int c = 0; c < 4; ++c) { gpre[c] = dpp0<DPP_SHR1>(Gv[3][c]); gnxt[c] = dpp0<DPP_SHL1>(Gv[0][c]); vpre[c] = dpp0<DPP_SHR1>(Vv[3][c]); vnxt[c] = dpp0<DPP_SHL1>(Vv[0][c]); }
#pragma unroll
                for (int m = 0; m < 4; ++m) {
                    const f32x4 gp = m > 0 ? Gv[m > 0 ? m - 1 : 0] : gpre, gn = m < 3 ? Gv[m < 3 ? m + 1 : 3] : gnxt;
                    const f32x4 vp = m > 0 ? Vv[m > 0 ? m - 1 : 0] : vpre, vn = m < 3 ? Vv[m < 3 ? m + 1 : 3] : vnxt;
                    const f32x4 zg = bg + gp * wg0 + Gv[m] * wg1 + gn * wg2;
                    const f32x4 zv = bv + vp * wv0 + Vv[m] * wv1 + vn * wv2;
                    const f32x4 ov4 = silu4(zg) * zv; const float o0 = ov4[0], o1 = ov4[1], o2 = ov4[2], o3 = ov4[3];
                    const int row = u.pm * 256 + ai * 128 + wr * 64 + 4 * fr + m;
                    *(u32x2*)(ACT + (size_t)row * FF + jg) = (u32x2){pk2(o0, o1), pk2(o2, o3)};
                }
            }
        }
    }
};
__device__ __forceinline__ void transpose_item(const float* W, int K, int N, bf16* WT, LAS float* scr, int item, int lane, const float* gk = nullptr, const bool up_perm = false) {
    const int nblk = N / 32, kb = item / nblk, nb = item % nblk, k0 = 64 * kb, n0 = 32 * nb;
    const int r0 = !up_perm ? n0 : (n0 < FF ? 256 * (n0 >> 7) + (n0 & 127) : 256 * ((n0 - FF) >> 7) + 128 + ((n0 - FF) & 127));
    {
        const int rr = lane >> 3, c4 = (lane & 7) * 4;
        f32x4 v[8]; float gs[8];
#pragma unroll
        for (int i = 0; i < 8; ++i) { v[i] = *(const f32x4*)(W + (size_t)(k0 + rr + 8 * i) * N + n0 + c4); gs[i] = gk ? gk[k0 + rr + 8 * i] : 1.f; }
#pragma unroll
        for (int i = 0; i < 8; ++i) { LAS float* d = scr + (rr + 8 * i) * 33 + c4; d[0] = v[i][0] * gs[i]; d[1] = v[i][1] * gs[i]; d[2] = v[i][2] * gs[i]; d[3] = v[i][3] * gs[i]; }
    }
    asm volatile("s_waitcnt lgkmcnt(0)" ::: "memory");
    const int c = lane & 7;
#pragma unroll
    for (int j = 0; j < 4; ++j) { const int n = (lane >> 3) + 8 * j; const LAS float* s = scr + (8 * c) * 33 + n;
        u32x4 o; o.x = pk2(s[0 * 33], s[1 * 33]); o.y = pk2(s[2 * 33], s[3 * 33]); o.z = pk2(s[4 * 33], s[5 * 33]); o.w = pk2(s[6 * 33], s[7 * 33]);
        *(u32x4*)(WT + (size_t)(r0 + n) * K + k0 + 8 * c) = o; }
    asm volatile("s_waitcnt lgkmcnt(0)" ::: "memory");
}
__device__ __forceinline__ void convert_weights(const Args& a, int l, int which, LAS unsigned char* lds, int gw, int NGW, int wave, int lane) {
    LAS float* scr = (LAS float*)(lds + wave * 16384);
    const float* Win = a.in[2] + (size_t)l * D * NIN; const float* Wout = a.in[12] + (size_t)l * D * D;
    const float* Wup = a.in[14] + (size_t)l * D * NUP; const float* Wdn = a.in[17] + (size_t)l * FF * D;
    bf16* Win_t = (bf16*)(a.ws + WS_WIN); bf16* Wout_t = (bf16*)(a.ws + WS_WOUT); bf16* Wup_t = (bf16*)(a.ws + WS_WUP); bf16* Wdn_t = (bf16*)(a.ws + WS_WDOWN);
    constexpr int I_IN = (D / 64) * (NIN / 32), I_OUT = (D / 64) * (D / 32), I_UP = (D / 64) * (NUP / 32), I_DN = (FF / 64) * (D / 32);
    if (which & 1) {
        for (int it = gw; it < I_IN + I_OUT; it += NGW) {
            if (it < I_IN) transpose_item(Win, D, NIN, Win_t, scr, it, lane, a.in[1] + (size_t)l * D);
            else transpose_item(Wout, D, D, Wout_t, scr, it - I_IN, lane);
        }
        u32x4* pad = (u32x4*)(Win_t + (size_t)NIN * D);
        for (int i = gw * 64 + lane; i < (NINP - NIN) * D / 8; i += NGW * 64) pad[i] = (u32x4){0u, 0u, 0u, 0u};
    }
    if (which & 4) for (int it = gw; it < I_UP; it += NGW) transpose_item(Wup, D, NUP, Wup_t, scr, it, lane, a.in[13] + (size_t)l * D, true);
    if (which & 2) for (int it = gw; it < I_DN; it += NGW) transpose_item(Wdn, FF, D, Wdn_t, scr, it, lane);
}
__device__ __forceinline__ void prologue_rows(const float* X, const float* g, bf16* XN, float* ss, int gw, int NGW, int lane) {
    f32x4 gv[4];
#pragma unroll
    for (int j = 0; j < 4; ++j) gv[j] = ((const f32x4*)g)[lane + 64 * j];
    for (int m = gw; m < M; m += NGW) {
        const f32x4* xr = (const f32x4*)(X + (size_t)m * D) + lane; f32x4 v[4]; float s = 0.f;
#pragma unroll
        for (int j = 0; j < 4; ++j) { v[j] = xr[64 * j]; s += (v[j].x * v[j].x + v[j].y * v[j].y) + (v[j].z * v[j].z + v[j].w * v[j].w); }
        s = wave_sum(s);
        if (lane == 0) *(f32x4*)(ss + (size_t)m * 4) = (f32x4){s, 0.f, 0.f, 0.f};
        unsigned long long* o8 = (unsigned long long*)(XN + (size_t)m * D) + lane;
#pragma unroll
        for (int j = 0; j < 4; ++j) { const f32x4 y = v[j]; o8[64 * j] = (unsigned long long)pk2(y.x, y.y) | ((unsigned long long)pk2(y.z, y.w) << 32); }
    }
}
__device__ __forceinline__ void final_rows(float* X, const float* g, const float* ss, int gw, int NGW, int lane) {
    f32x4 gv[4];
#pragma unroll
    for (int j = 0; j < 4; ++j) gv[j] = ((const f32x4*)g)[lane + 64 * j];
    for (int m = gw; m < M; m += NGW) {
        f32x4* xr = (f32x4*)(X + (size_t)m * D) + lane; const float rstd = row_rstd(ss, m);
#pragma unroll
        for (int j = 0; j < 4; ++j) xr[64 * j] = xr[64 * j] * rstd * gv[j];
    }
}
#define LBAR() do { asm volatile("s_waitcnt lgkmcnt(0)" ::: "memory"); __builtin_amdgcn_s_barrier(); asm volatile("" ::: "memory"); } while (0)
template <int NT, int KS>
__device__ __forceinline__ void mma_rc(const LAS bf16* X, int ldx, int r0, const LAS bf16* Y, int ldy, int c0, f32x4 (&acc)[NT], int lane) {
    const int fr = lane & 15, fq = lane >> 4;
    const LAS bf16* yp = Y + (c0 + fr) * ldy + fq * 8;
    const LAS bf16* xp = X + (r0 + fr) * ldx + fq * 8;
#pragma unroll
    for (int ks = 0; ks < KS; ++ks) {
        const bf16x8 b = *(const LAS bf16x8*)(yp + ks * 32);
#pragma unroll
        for (int t = 0; t < NT; ++t) {
            const bf16x8 a = *(const LAS bf16x8*)(xp + t * 16 * ldx + ks * 32);
            acc[t] = __builtin_amdgcn_mfma_f32_16x16x32_bf16(a, b, acc[t], 0, 0, 0);
        }
    }
}
__device__ __forceinline__ void stage_rbuf(const bf16* P, int row0, LAS unsigned char* lds, int tid) {
    const int r = tid >> 2, part = tid & 3;
    const u32x4 v = *(const u32x4*)(P + (size_t)(row0 + r) * NINP + 2560 + part * 8);
    LAS f32x4* dst = (LAS f32x4*)(lds + RBUF_OFF + (r * 32 + part * 8) * 4);
    dst[0] = (f32x4){bf_lo(v.x), bf_hi(v.x), bf_lo(v.y), bf_hi(v.y)};
    dst[1] = (f32x4){bf_lo(v.z), bf_hi(v.z), bf_lo(v.w), bf_hi(v.w)};
}
template <bool LN>
__device__ __forceinline__ void stage_T(const bf16* P, int row0, int col0, LAS unsigned char* buf, int wave, int lane, const float* lng, const float* lnb) {
    float a[16], b[16];
    const bf16* src = P + (size_t)(row0 + 16 * wave) * NINP + col0 + 2 * lane;
#pragma unroll
    for (int s = 0; s < 16; ++s) { const unsigned v = *(const unsigned*)(src + (size_t)s * NINP); a[s] = bf_lo(v); b[s] = bf_hi(v); }
    if (LN) {
        const f32x2 g = *(const f32x2*)(lng + 2 * lane), bb = *(const f32x2*)(lnb + 2 * lane);
#pragma unroll
        for (int s = 0; s < 16; ++s) {
            const float mu = wave_sum(a[s] + b[s]) * (1.f / 128.f);
            const float da = a[s] - mu, db = b[s] - mu;
            const float rstd = rsqrtf(wave_sum(da * da + db * db) * (1.f / 128.f) + EPS);
            a[s] = da * rstd * g.x + bb.x; b[s] = db * rstd * g.y + bb.y;
        }
    }
    LAS u32x4* d0 = (LAS u32x4*)(buf + ((2 * lane) * LDT + 16 * wave) * 2);
    LAS u32x4* d1 = (LAS u32x4*)(buf + ((2 * lane + 1) * LDT + 16 * wave) * 2);
    d0[0] = (u32x4){pk2(a[0], a[1]), pk2(a[2], a[3]), pk2(a[4], a[5]), pk2(a[6], a[7])};
    d0[1] = (u32x4){pk2(a[8], a[9]), pk2(a[10], a[11]), pk2(a[12], a[13]), pk2(a[14], a[15])};
    d1[0] = (u32x4){pk2(b[0], b[1]), pk2(b[2], b[3]), pk2(b[4], b[5]), pk2(b[6], b[7])};
    d1[1] = (u32x4){pk2(b[8], b[9]), pk2(b[10], b[11]), pk2(b[12], b[13]), pk2(b[14], b[15])};
}
struct CumState { float cf[2][8], cb[2][8], tf[2], tb[2]; };
struct GateW { f32x2 wf[16], wb[16], bf, bb; };
__device__ __forceinline__ void gate_dir(const f32x2 (&wv)[16], const f32x2 bv, const LAS unsigned char* rb, float (&la)[2][8]) {
#pragma unroll
    for (int s = 0; s < 8; ++s) {
        const LAS f32x4* r = (const LAS f32x4*)(rb + s * 128);
        f32x2 pp = bv;
#pragma unroll
        for (int q = 0; q < 4; ++q) { const f32x4 rv = r[q];
#pragma unroll
            for (int e = 0; e < 4; ++e) pp = __builtin_elementwise_fma((f32x2){rv[e], rv[e]}, wv[4 * q + e], pp); }
        la[0][s] = logsig_f(pp.x) * (0.0625f * 1.44269504089f); la[1][s] = logsig_f(pp.y) * (0.0625f * 1.44269504089f);
        if (s & 1) __builtin_amdgcn_sched_barrier(0);
    }
}
__device__ __forceinline__ void compute_cum(const GateW& gwt, LAS unsigned char* lds, int wave, int lane, CumState& C) {
    const int p = lane & 31, seg = 2 * wave + (lane >> 5);
    const LAS unsigned char* rb = lds + RBUF_OFF + (8 * seg) * 128;
    gate_dir(gwt.wf, gwt.bf, rb, C.cf);
    { float r0 = 0.f, r1 = 0.f;
#pragma unroll
      for (int s = 0; s < 8; ++s) { r0 += C.cf[0][s]; r1 += C.cf[1][s]; C.cf[0][s] = r0; C.cf[1][s] = r1; } }
    __builtin_amdgcn_sched_barrier(0);
    gate_dir(gwt.wb, gwt.bb, rb + 64, C.cb);
    { float r0 = 0.f, r1 = 0.f;
#pragma unroll
      for (int s = 7; s >= 0; --s) { r0 += C.cb[0][s]; r1 += C.cb[1][s]; C.cb[0][s] = r0; C.cb[1][s] = r1; } }
    __builtin_amdgcn_sched_barrier(0);
    LAS float* tot = (LAS float*)(lds + TOT_OFF);
    *(LAS f32x2*)(tot + seg * 64 + 2 * p) = (f32x2){C.cf[0][7], C.cf[1][7]};
    *(LAS f32x2*)(tot + (16 + seg) * 64 + 2 * p) = (f32x2){C.cb[0][0], C.cb[1][0]};
    LBAR();
    float of0 = 0.f, of1 = 0.f, tf0 = 0.f, tf1 = 0.f, ob0 = 0.f, ob1 = 0.f, tb0 = 0.f, tb1 = 0.f;
#pragma unroll
    for (int sg = 0; sg < 16; ++sg) {
        const f32x2 x = *(const LAS f32x2*)(tot + sg * 64 + 2 * p), y = *(const LAS f32x2*)(tot + (16 + sg) * 64 + 2 * p);
        tf0 += x.x; tf1 += x.y; tb0 += y.x; tb1 += y.y;
        if (sg < seg) { of0 += x.x; of1 += x.y; }
        if (sg > seg) { ob0 += y.x; ob1 += y.y; }
    }
#pragma unroll
    for (int s = 0; s < 8; ++s) { C.cf[0][s] += of0; C.cf[1][s] += of1; C.cb[0][s] += ob0; C.cb[1][s] += ob1; }
    C.tf[0] = tf0; C.tf[1] = tf1; C.tb[0] = tb0; C.tb[1] = tb1;
    __builtin_amdgcn_sched_barrier(0);
}
__device__ __forceinline__ void mixer_a_item(const Args& a, int l, int item, LAS unsigned char* lds, int tid, int wave, int lane) {
    asm volatile("" : "+v"(tid)); lane = tid & 63;
    const int h = item & 3, row0 = (item >> 2) * 128;
    const bf16* P = (const bf16*)(a.ws + WS_P);
    const int p = lane & 31, seg = 2 * wave + (lane >> 5);
    LBAR();
    GateW gwt;
    { const int co = l * 256 + h * 64 + 2 * p; const float* wgf = a.in[7] + (size_t)l * 16 * 256 + h * 64 + 2 * p; const float* wgb = a.in[9] + (size_t)l * 16 * 256 + h * 64 + 2 * p;
#pragma unroll
      for (int t = 0; t < 16; ++t) { gwt.wf[t] = *(const f32x2*)(wgf + t * 256); gwt.wb[t] = *(const f32x2*)(wgb + t * 256); }
      gwt.bf = *(const f32x2*)(a.in[8] + co); gwt.bb = *(const f32x2*)(a.in[10] + co); }
    unsigned kraw[8];
    { const bf16* kp = P + (size_t)(row0 + 8 * seg) * NINP + 1280 + h * 64 + 2 * p;
#pragma unroll
    for (int s = 0; s < 8; ++s) kraw[s] = *(const unsigned*)(kp + (size_t)s * NINP); }
    stage_rbuf(P, row0, lds, tid);
    stage_T<false>(P, row0, 1536 + h * 128, lds + MB0, wave, lane, nullptr, nullptr);
    LBAR();
    CumState C; compute_cum(gwt, lds, wave, lane, C);
    { f32x4* cq = (f32x4*)(a.ws + WS_CUM) + (size_t)item * 4096 + tid;
      cq[0] = (f32x4){C.cf[0][0], C.cf[0][1], C.cf[0][2], C.cf[0][3]}; cq[512] = (f32x4){C.cf[0][4], C.cf[0][5], C.cf[0][6], C.cf[0][7]};
      cq[1024] = (f32x4){C.cf[1][0], C.cf[1][1], C.cf[1][2], C.cf[1][3]}; cq[1536] = (f32x4){C.cf[1][4], C.cf[1][5], C.cf[1][6], C.cf[1][7]};
      cq[2048] = (f32x4){C.cb[0][0], C.cb[0][1], C.cb[0][2], C.cb[0][3]}; cq[2560] = (f32x4){C.cb[0][4], C.cb[0][5], C.cb[0][6], C.cb[0][7]};
      cq[3072] = (f32x4){C.cb[1][0], C.cb[1][1], C.cb[1][2], C.cb[1][3]}; cq[3584] = (f32x4){C.cb[1][4], C.cb[1][5], C.cb[1][6], C.cb[1][7]}; }
    float k0[8], k1[8];
#pragma unroll
    for (int s = 0; s < 8; ++s) { k0[s] = bf_lo(kraw[s]); k1[s] = bf_hi(kraw[s]); }
    {
        const f32x2 tf2 = (f32x2){C.tf[0], C.tf[1]}, tb2 = (f32x2){C.tb[0], C.tb[1]};
        float ef0[8], ef1[8], eb0[8], eb1[8];
#pragma unroll
        for (int s = 0; s < 8; ++s) {
            const f32x2 k2 = (f32x2){k0[s], k1[s]};
            const f32x2 af = tf2 - (f32x2){C.cf[0][s], C.cf[1][s]}, ab = tb2 - (f32x2){C.cb[0][s], C.cb[1][s]};
            const f32x2 rf = k2 * (f32x2){__builtin_amdgcn_exp2f(af.x), __builtin_amdgcn_exp2f(af.y)}, rb2 = k2 * (f32x2){__builtin_amdgcn_exp2f(ab.x), __builtin_amdgcn_exp2f(ab.y)};
            ef0[s] = rf.x; ef1[s] = rf.y; eb0[s] = rb2.x; eb1[s] = rb2.y;
        }
        *(LAS u32x4*)(lds + MB2 + ((2 * p) * LDT + 8 * seg) * 2) = (u32x4){pk2(ef0[0], ef0[1]), pk2(ef0[2], ef0[3]), pk2(ef0[4], ef0[5]), pk2(ef0[6], ef0[7])};
        *(LAS u32x4*)(lds + MB2 + ((2 * p + 1) * LDT + 8 * seg) * 2) = (u32x4){pk2(ef1[0], ef1[1]), pk2(ef1[2], ef1[3]), pk2(ef1[4], ef1[5]), pk2(ef1[6], ef1[7])};
        *(LAS u32x4*)(lds + MB2 + ((64 + 2 * p) * LDT + 8 * seg) * 2) = (u32x4){pk2(eb0[0], eb0[1]), pk2(eb0[2], eb0[3]), pk2(eb0[4], eb0[5]), pk2(eb0[6], eb0[7])};
        *(LAS u32x4*)(lds + MB2 + ((64 + 2 * p + 1) * LDT + 8 * seg) * 2) = (u32x4){pk2(eb1[0], eb1[1]), pk2(eb1[2], eb1[3]), pk2(eb1[4], eb1[5]), pk2(eb1[6], eb1[7])};
    }
    if (seg == 0) { float* dec = (float*)(a.ws + WS_DEC) + (size_t)item * 128;
        *(f32x2*)(dec + 2 * p) = (f32x2){__builtin_amdgcn_exp2f(C.tf[0]), __builtin_amdgcn_exp2f(C.tf[1])}; *(f32x2*)(dec + 64 + 2 * p) = (f32x2){__builtin_amdgcn_exp2f(C.tb[0]), __builtin_amdgcn_exp2f(C.tb[1])}; }
    LBAR();
    const int dir = wave >> 2, r0 = 32 * (wave & 3), fr = lane & 15, fq = lane >> 4;
    float* DS = (float*)(a.ws + WS_DS) + (size_t)(item * 2 + dir) * 8192 + (r0 + 4 * fq) * 64 + fr;
#pragma unroll
    for (int n = 0; n < 4; ++n) {
        f32x4 acc[2] = {(f32x4){0.f, 0.f, 0.f, 0.f}, (f32x4){0.f, 0.f, 0.f, 0.f}};
        mma_rc<2, 4>((const LAS bf16*)(lds + MB0), LDT, r0, (const LAS bf16*)(lds + MB2) + dir * 64 * LDT, LDT, 16 * n, acc, lane);
#pragma unroll
        for (int t = 0; t < 2; ++t)
#pragma unroll
            for (int r = 0; r < 4; ++r) DS[(16 * t + r) * 64 + 16 * n] = acc[t][r];
    }
}
__device__ __forceinline__ void mixer_scan(const Args& a, int tid) {
    const float* DS = (const float*)(a.ws + WS_DS); const float* DEC = (const float*)(a.ws + WS_DEC); bf16* ST = (bf16*)(a.ws + WS_ST);
    for (int gid = blockIdx.x * NTHR + tid; gid < 16 * 8192; gid += gridDim.x * NTHR) {
        const int elem = gid & 8191, sq = gid >> 13, b = sq >> 3, h = (sq >> 1) & 3, dir = sq & 1;
        const long blk0 = (long)(((b * 64) * 4 + h) * 2 + dir) + (dir ? 63 * 8 : 0); const long bstep = dir ? -8 : 8;
        const float* dsp = DS + blk0 * 8192 + elem; const float* dcp = DEC + blk0 * 64 + (elem & 63); bf16* stp = ST + blk0 * 8192 + elem;
        float ds[64], dc[64];
#pragma unroll
        for (int s = 0; s < 64; ++s) { ds[s] = dsp[(long)s * bstep * 8192]; dc[s] = dcp[(long)s * bstep * 64]; }
        float S = 0.f;
#pragma unroll
        for (int s = 0; s < 64; ++s) { stp[(long)s * bstep * 8192] = (bf16)f2bf(S); S = S * dc[s] + ds[s]; }
    }
}
__device__ __forceinline__ void mixer_gla_item(const Args& a, int l, int item, LAS unsigned char* lds, int tid, int wave, int lane, const XcdBarrier& xb, const bool first) {
    asm volatile("" : "+v"(tid)); lane = tid & 63;
    const int h = item & 3, row0 = (item >> 2) * 128;
    const bf16* P = (const bf16*)(a.ws + WS_P); bf16* MIX = (bf16*)(a.ws + WS_MIX); const bf16* ST = (const bf16*)(a.ws + WS_ST);
    const int p = lane & 31, seg = 2 * wave + (lane >> 5), fr = lane & 15, fq = lane >> 4, w = wave;
    const int orow = row0 + 16 * w + fr;
    LBAR();
    unsigned vraw[16];
    { const bf16* src = P + (size_t)(row0 + 16 * wave) * NINP + 1536 + h * 128 + 2 * lane;
#pragma unroll
      for (int s = 0; s < 16; ++s) vraw[s] = *(const unsigned*)(src + (size_t)s * NINP); }
    unsigned qv[8], kv[8];
    { const bf16* prb = P + (size_t)(row0 + 8 * seg) * NINP + h * 64 + 2 * p;
#pragma unroll
      for (int s = 0; s < 8; ++s) { qv[s] = *(const unsigned*)(prb + (size_t)s * NINP + 1024); kv[s] = *(const unsigned*)(prb + (size_t)s * NINP + 1280); } }
    f32x4 cq[8];
    { const f32x4* cp = (const f32x4*)(a.ws + WS_CUM) + (size_t)item * 4096 + tid;
#pragma unroll
      for (int j = 0; j < 8; ++j) cq[j] = cp[512 * j]; }
    u32x2 pgv[8];
    { const bf16* pg = P + (size_t)orow * NINP + 2048 + h * 128 + 4 * fq;
#pragma unroll
      for (int t = 0; t < 8; ++t) pgv[t] = *(const u32x2*)(pg + 16 * t); }
    { LAS u32x4* d0 = (LAS u32x4*)(lds + MB0 + ((2 * lane) * LDT + 16 * wave) * 2); LAS u32x4* d1 = (LAS u32x4*)(lds + MB0 + ((2 * lane + 1) * LDT + 16 * wave) * 2);
#define LO2(x, y) (((x) & 0xffffu) | ((y) << 16))
#define HI2(x, y) (((x) >> 16) | ((y) & 0xffff0000u))
      d0[0] = (u32x4){LO2(vraw[0], vraw[1]), LO2(vraw[2], vraw[3]), LO2(vraw[4], vraw[5]), LO2(vraw[6], vraw[7])};
      d0[1] = (u32x4){LO2(vraw[8], vraw[9]), LO2(vraw[10], vraw[11]), LO2(vraw[12], vraw[13]), LO2(vraw[14], vraw[15])};
      d1[0] = (u32x4){HI2(vraw[0], vraw[1]), HI2(vraw[2], vraw[3]), HI2(vraw[4], vraw[5]), HI2(vraw[6], vraw[7])};
      d1[1] = (u32x4){HI2(vraw[8], vraw[9]), HI2(vraw[10], vraw[11]), HI2(vraw[12], vraw[13]), HI2(vraw[14], vraw[15])}; }
    CumState C;
#pragma unroll
    for (int q = 0; q < 4; ++q) { C.cf[0][q] = cq[0][q]; C.cf[0][4 + q] = cq[1][q]; C.cf[1][q] = cq[2][q]; C.cf[1][4 + q] = cq[3][q]; C.cb[0][q] = cq[4][q]; C.cb[0][4 + q] = cq[5][q]; C.cb[1][q] = cq[6][q]; C.cb[1][4 + q] = cq[7][q]; }
    { LAS unsigned char* qdb = lds + MB2 + (8 * seg * LDT + 2 * p) * 2; LAS unsigned char* kib = lds + MB3 + (8 * seg * LDK + 2 * p) * 2;
#pragma unroll
      for (int s = 0; s < 8; ++s) {
        const f32x2 q2 = (f32x2){bf_lo(qv[s]), bf_hi(qv[s])}, k2 = (f32x2){bf_lo(kv[s]), bf_hi(kv[s])};
        const f32x2 ef = (f32x2){__builtin_amdgcn_exp2f(C.cf[0][s]), __builtin_amdgcn_exp2f(C.cf[1][s])}, eb = (f32x2){__builtin_amdgcn_exp2f(C.cb[0][s]), __builtin_amdgcn_exp2f(C.cb[1][s])};
        const f32x2 nf = (f32x2){__builtin_amdgcn_exp2f(-C.cf[0][s]), __builtin_amdgcn_exp2f(-C.cf[1][s])}, nb = (f32x2){__builtin_amdgcn_exp2f(-C.cb[0][s]), __builtin_amdgcn_exp2f(-C.cb[1][s])};
        const f32x2 qf = q2 * ef, qb = q2 * eb, kf = k2 * nf, kb = k2 * nb;
        *(LAS unsigned*)(qdb + s * LDT * 2) = pk2(qf.x, qf.y);
        *(LAS unsigned*)(qdb + s * LDT * 2 + 128) = pk2(qb.x, qb.y);
        *(LAS unsigned*)(kib + s * LDK * 2) = pk2(kf.x, kf.y);
        *(LAS unsigned*)(kib + (128 + s) * LDK * 2) = pk2(kb.x, kb.y);
        if (s & 1) __builtin_amdgcn_sched_barrier(0);
      } }
    LBAR();
    if (first) xcd_wait(xb, tid);
    u32x4 stv[4];
#pragma unroll
    for (int q = 0; q < 4; ++q) { const int c = tid + NTHR * q, dir = c >> 10, cc = c & 1023; stv[q] = *(const u32x4*)(ST + (size_t)(item * 2 + dir) * 8192 + (cc >> 3) * 64 + (cc & 7) * 8); }
#pragma unroll
    for (int t = 0; t < 8; ++t) {
        f32x4 sf[1] = {(f32x4){0.f, 0.f, 0.f, 0.f}}, sb[1] = {(f32x4){0.f, 0.f, 0.f, 0.f}};
        if (t <= w) mma_rc<1, 2>((const LAS bf16*)(lds + MB3), LDK, 16 * t, (const LAS bf16*)(lds + MB2), LDT, 16 * w, sf, lane);
        if (t >= w) mma_rc<1, 2>((const LAS bf16*)(lds + MB3) + 128 * LDK, LDK, 16 * t, (const LAS bf16*)(lds + MB2) + 64, LDT, 16 * w, sb, lane);
        const int i = 16 * w + fr, j0 = 16 * t + 4 * fq;
        float v[4];
#pragma unroll
        for (int r = 0; r < 4; ++r) v[r] = (j0 + r <= i) ? sf[0][r] : sb[0][r];
        *(LAS u32x2*)(lds + MB1 + (i * LDT + 4 * fq) * 2 + 32 * t) = (u32x2){pk2(v[0], v[1]), pk2(v[2], v[3])};
    }
    LBAR();
#pragma unroll
    for (int q = 0; q < 4; ++q) { const int c = tid + NTHR * q, dir = c >> 10, cc = c & 1023; *(LAS u32x4*)(lds + MB3 + ((cc >> 3) * LDT + dir * 64 + (cc & 7) * 8) * 2) = stv[q]; }
    f32x4 acc[8];
#pragma unroll
    for (int t = 0; t < 8; ++t) acc[t] = (f32x4){0.f, 0.f, 0.f, 0.f};
    mma_rc<8, 4>((const LAS bf16*)(lds + MB0), LDT, 0, (const LAS bf16*)(lds + MB1), LDT, 16 * w, acc, lane);
    LBAR();
    mma_rc<8, 4>((const LAS bf16*)(lds + MB3), LDT, 0, (const LAS bf16*)(lds + MB2), LDT, 16 * w, acc, lane);
    {   float ss = 0.f;
#pragma unroll
        for (int t = 0; t < 8; ++t) ss += (acc[t][0] * acc[t][0] + acc[t][1] * acc[t][1]) + (acc[t][2] * acc[t][2] + acc[t][3] * acc[t][3]);
        ss += __shfl_xor(ss, 16); ss += __shfl_xor(ss, 32);
        const float rstd = rsqrtf(ss * (1.f / 128.f) + EPS);
        const float* gg = a.in[11] + (size_t)(l * 4 + h) * 128 + 4 * fq; bf16* mo = MIX + (size_t)orow * D + 512 + h * 128 + 4 * fq;
        f32x4 g4a[8];
#pragma unroll
        for (int t = 0; t < 8; ++t) g4a[t] = *(const f32x4*)(gg + 16 * t);
#pragma unroll
        for (int t = 0; t < 8; ++t) { const f32x4 g4 = g4a[t];
            const f32x4 ov4 = (acc[t] * rstd) * g4 * silu4((f32x4){bf_lo(pgv[t].x), bf_hi(pgv[t].x), bf_lo(pgv[t].y), bf_hi(pgv[t].y)});
            const float o0 = ov4[0], o1 = ov4[1], o2 = ov4[2], o3 = ov4[3];
            *(u32x2*)(mo + 16 * t) = (u32x2){pk2(o0, o1), pk2(o2, o3)}; } }
}
__device__ __forceinline__ void mixer_gmlp_item(const Args& a, int l, int item, LAS unsigned char* lds, int tid, int wave, int lane) {
    asm volatile("" : "+v"(tid)); lane = tid & 63;
    const int h = item & 3, row0 = (item >> 2) * 128;
    const bf16* P = (const bf16*)(a.ws + WS_P); bf16* MIX = (bf16*)(a.ws + WS_MIX);
    const int fr = lane & 15, fq = lane >> 4, w = wave;
    const int orow = row0 + 16 * w + fr;
    LBAR();
    f32x4 wsv[8];
    { const float* Ws = a.in[3] + (size_t)(l * 4 + h) * 16384 + (tid >> 2) * 128 + (tid & 3) * 32;
#pragma unroll
      for (int q = 0; q < 8; ++q) wsv[q] = *(const f32x4*)(Ws + 4 * q); }
    unsigned araw[16];
    { const bf16* src = P + (size_t)(row0 + 16 * wave) * NINP + 512 + h * 128 + 2 * lane;
#pragma unroll
      for (int s = 0; s < 16; ++s) araw[s] = *(const unsigned*)(src + (size_t)s * NINP); }
    u32x2 uv[8];
    { const bf16* up = P + (size_t)orow * NINP + h * 128 + 4 * fq;
#pragma unroll
      for (int t = 0; t < 8; ++t) uv[t] = *(const u32x2*)(up + 16 * t); }
    { const int r = tid >> 2, cp = (tid & 3) * 32;
#pragma unroll
      for (int q = 0; q < 4; ++q) *(LAS u32x4*)(lds + MB1 + (r * LDT + cp + 8 * q) * 2) = (u32x4){pk2(wsv[2 * q][0], wsv[2 * q][1]), pk2(wsv[2 * q][2], wsv[2 * q][3]), pk2(wsv[2 * q + 1][0], wsv[2 * q + 1][1]), pk2(wsv[2 * q + 1][2], wsv[2 * q + 1][3])}; }
    { float av[16], bv[16];
      const f32x2 g = *(const f32x2*)(a.in[5] + (size_t)(l * 4 + h) * 128 + 2 * lane), bb = *(const f32x2*)(a.in[6] + (size_t)(l * 4 + h) * 128 + 2 * lane);
#pragma unroll
      for (int s = 0; s < 16; ++s) {
          const f32x2 xv = (f32x2){bf_lo(araw[s]), bf_hi(araw[s])};
          const float mu = wave_sum_dpp(xv.x + xv.y) * (1.f / 128.f);
          const f32x2 dv = xv - mu, sq = dv * dv;
          const float rstd = rsqrtf(wave_sum_dpp(sq.x + sq.y) * (1.f / 128.f) + EPS);
          const f32x2 ov2 = __builtin_elementwise_fma(dv * rstd, g, bb);
          av[s] = ov2.x; bv[s] = ov2.y;
      }
      LAS u32x4* d0 = (LAS u32x4*)(lds + MB0 + ((2 * lane) * LDT + 16 * wave) * 2); LAS u32x4* d1 = (LAS u32x4*)(lds + MB0 + ((2 * lane + 1) * LDT + 16 * wave) * 2);
      d0[0] = (u32x4){pk2(av[0], av[1]), pk2(av[2], av[3]), pk2(av[4], av[5]), pk2(av[6], av[7])};
      d0[1] = (u32x4){pk2(av[8], av[9]), pk2(av[10], av[11]), pk2(av[12], av[13]), pk2(av[14], av[15])};
      d1[0] = (u32x4){pk2(bv[0], bv[1]), pk2(bv[2], bv[3]), pk2(bv[4], bv[5]), pk2(bv[6], bv[7])};
      d1[1] = (u32x4){pk2(bv[8], bv[9]), pk2(bv[10], bv[11]), pk2(bv[12], bv[13]), pk2(bv[14], bv[15])}; }
    LBAR();
    f32x4 acc[8];
#pragma unroll
    for (int t = 0; t < 8; ++t) acc[t] = (f32x4){0.f, 0.f, 0.f, 0.f};
    mma_rc<8, 4>((const LAS bf16*)(lds + MB0), LDT, 0, (const LAS bf16*)(lds + MB1), LDT, 16 * w, acc, lane);
    {   const float bsv = a.in[4][(size_t)(l * 4 + h) * 128 + 16 * w + fr];
        bf16* mo = MIX + (size_t)orow * D + h * 128 + 4 * fq;
#pragma unroll
        for (int t = 0; t < 8; ++t) {
            const f32x4 ov4 = (f32x4){bf_lo(uv[t].x), bf_hi(uv[t].x), bf_lo(uv[t].y), bf_hi(uv[t].y)} * (acc[t] + bsv); const float o0 = ov4[0], o1 = ov4[1], o2 = ov4[2], o3 = ov4[3];
            *(u32x2*)(mo + 16 * t) = (u32x2){pk2(o0, o1), pk2(o2, o3)}; } }
}
__device__ __forceinline__ void unpack8(const u32x4 v, float (&f)[8]) { f[0] = bf_lo(v.x); f[1] = bf_hi(v.x); f[2] = bf_lo(v.y); f[3] = bf_hi(v.y); f[4] = bf_lo(v.z); f[5] = bf_hi(v.z); f[6] = bf_lo(v.w); f[7] = bf_hi(v.w); }
__device__ __forceinline__ void conv_act(const Args& a, int l, int tid) {
    const bf16* Y = (const bf16*)(a.ws + WS_R1); bf16* ACT = (bf16*)(a.ws + WS_R2);
    const float* cw = a.in[15] + (size_t)l * 3 * NUP; const float* cb = a.in[16] + (size_t)l * NUP;
    constexpr int NCG = FF / 8, NT = (M / 8) * NCG;
    for (int t = blockIdx.x * NTHR + tid; t < NT; t += gridDim.x * NTHR) {
        const int cgp = t % NCG, rg = t / NCG, j0 = cgp * 8, m0 = rg * 8, pos = m0 & (SEQ - 1);
        float wg[3][8], wv[3][8], bg[8], bv[8];
#pragma unroll
        for (int k = 0; k < 3; ++k)
#pragma unroll
            for (int q = 0; q < 2; ++q) { const f32x4 x = *(const f32x4*)(cw + k * NUP + j0 + 4 * q), y = *(const f32x4*)(cw + k * NUP + FF + j0 + 4 * q);
#pragma unroll
                for (int e = 0; e < 4; ++e) { wg[k][4 * q + e] = x[e]; wv[k][4 * q + e] = y[e]; } }
#pragma unroll
        for (int q = 0; q < 2; ++q) { const f32x4 x = *(const f32x4*)(cb + j0 + 4 * q), y = *(const f32x4*)(cb + FF + j0 + 4 * q);
#pragma unroll
            for (int e = 0; e < 4; ++e) { bg[4 * q + e] = x[e]; bv[4 * q + e] = y[e]; } }
        float pg[8], pv[8], cgv[8], cv[8], ng[8], nv[8];
        const bf16* yr = Y + (size_t)m0 * NUP + j0;
        if (pos > 0) { unpack8(*(const u32x4*)(yr - NUP), pg); unpack8(*(const u32x4*)(yr - NUP + FF), pv); }
        else {
#pragma unroll
            for (int e = 0; e < 8; ++e) { pg[e] = 0.f; pv[e] = 0.f; } }
        unpack8(*(const u32x4*)(yr), cgv); unpack8(*(const u32x4*)(yr + FF), cv);
#pragma unroll
        for (int r = 0; r < 8; ++r) {
            if (r < 7 || pos + 8 < SEQ) { unpack8(*(const u32x4*)(yr + (size_t)(r + 1) * NUP), ng); unpack8(*(const u32x4*)(yr + (size_t)(r + 1) * NUP + FF), nv); }
            else {
#pragma unroll
                for (int e = 0; e < 8; ++e) { ng[e] = 0.f; nv[e] = 0.f; } }
            float o[8];
#pragma unroll
            for (int e = 0; e < 8; ++e) { const float zg = bg[e] + pg[e] * wg[0][e] + cgv[e] * wg[1][e] + ng[e] * wg[2][e];
                const float zv = bv[e] + pv[e] * wv[0][e] + cv[e] * wv[1][e] + nv[e] * wv[2][e]; o[e] = silu_f(zg) * zv; }
            *(u32x4*)(ACT + (size_t)(m0 + r) * FF + j0) = (u32x4){pk2(o[0], o[1]), pk2(o[2], o[3]), pk2(o[4], o[5]), pk2(o[6], o[7])};
#pragma unroll
            for (int e = 0; e < 8; ++e) { pg[e] = cgv[e]; pv[e] = cv[e]; cgv[e] = ng[e]; cv[e] = nv[e]; }
        }
    }
}

__device__ __forceinline__ void conv_fix(const Args& a, int l, int tid) {
    const bf16* YB = (const bf16*)(a.ws + WS_R1); bf16* ACT = (bf16*)(a.ws + WS_R2);
    const float* cw = a.in[15] + (size_t)l * 3 * NUP; const float* cb = a.in[16] + (size_t)l * NUP;
    constexpr int NCG = FF / 8, NT = (M / 64) * 2 * NCG;
    for (int t = blockIdx.x * NTHR + tid; t < NT; t += gridDim.x * NTHR) {
        const int cgp = t % NCG, bw = t / NCG, which = bw & 1, blk = bw >> 1, j0 = cgp * 8;
        const int colg = 256 * (j0 >> 7) + (j0 & 127), row = blk * 64 + (which ? 63 : 0), pos = row & (SEQ - 1);
        float wg[3][8], wv[3][8], bg[8], bv[8];
#pragma unroll
        for (int k = 0; k < 3; ++k)
#pragma unroll
            for (int q = 0; q < 2; ++q) { const f32x4 x = *(const f32x4*)(cw + k * NUP + j0 + 4 * q), y = *(const f32x4*)(cw + k * NUP + FF + j0 + 4 * q);
#pragma unroll
                for (int e = 0; e < 4; ++e) { wg[k][4 * q + e] = x[e]; wv[k][4 * q + e] = y[e]; } }
#pragma unroll
        for (int q = 0; q < 2; ++q) { const f32x4 x = *(const f32x4*)(cb + j0 + 4 * q), y = *(const f32x4*)(cb + FF + j0 + 4 * q);
#pragma unroll
            for (int e = 0; e < 4; ++e) { bg[4 * q + e] = x[e]; bv[4 * q + e] = y[e]; } }
        const bf16* yb = YB + (size_t)(blk * 4) * NUP + colg;
        const bf16* pp = which ? yb + 2 * (size_t)NUP : yb - (size_t)NUP;
        const bf16* cp = which ? yb + 3 * (size_t)NUP : yb;
        const bf16* np = which ? yb + 4 * (size_t)NUP : yb + (size_t)NUP;
        const bool hasp = which || pos > 0, hasn = !which || pos < SEQ - 1;
        float pg[8], pv[8], cgv[8], cv[8], ng[8], nv[8];
        if (hasp) { unpack8(*(const u32x4*)pp, pg); unpack8(*(const u32x4*)(pp + 128), pv); }
        else {
#pragma unroll
            for (int e = 0; e < 8; ++e) { pg[e] = 0.f; pv[e] = 0.f; } }
        unpack8(*(const u32x4*)cp, cgv); unpack8(*(const u32x4*)(cp + 128), cv);
        if (hasn) { unpack8(*(const u32x4*)np, ng); unpack8(*(const u32x4*)(np + 128), nv); }
        else {
#pragma unroll
            for (int e = 0; e < 8; ++e) { ng[e] = 0.f; nv[e] = 0.f; } }
        float o[8];
#pragma unroll
        for (int e = 0; e < 8; ++e) { const float zg = bg[e] + pg[e] * wg[0][e] + cgv[e] * wg[1][e] + ng[e] * wg[2][e];
            const float zv = bv[e] + pv[e] * wv[0][e] + cv[e] * wv[1][e] + nv[e] * wv[2][e]; o[e] = silu_f(zg) * zv; }
        *(u32x4*)(ACT + (size_t)row * FF + j0) = (u32x4){pk2(o[0], o[1]), pk2(o[2], o[3]), pk2(o[4], o[5]), pk2(o[6], o[7])};
    }
}

#ifndef DUP_MASK
#define DUP_MASK 0
#endif
typedef const __attribute__((address_space(4))) Args* KArgsPtr;
__device__ __forceinline__ const Args& kargs() { KArgsPtr p = (KArgsPtr)__builtin_amdgcn_kernarg_segment_ptr(); asm volatile("" : "+s"(p)); return *(const Args*)p; }
__device__ __forceinline__ int lane_id() { return (int)__builtin_amdgcn_mbcnt_hi(~0u, __builtin_amdgcn_mbcnt_lo(~0u, 0u)); }
constexpr int NPH_L = 8;
template <int L, int S>
__device__ __forceinline__ void phase_body(LAS unsigned char* lds, const int wave_s, const XcdBarrier& xb) {
    const Args& a = kargs();
    int lane = lane_id(); asm volatile("" : "+v"(lane));
    const int wave = wave_s, tid = wave * 64 + lane, gw = blockIdx.x * 8 + wave;
    const int G = gridDim.x, NGW = G * 8;
    bf16* XB = (bf16*)(a.ws + WS_XB); bf16* Pb = (bf16*)(a.ws + WS_P); bf16* MIX = (bf16*)(a.ws + WS_MIX); bf16* Yb = (bf16*)(a.ws + WS_R1); bf16* ACT = (bf16*)(a.ws + WS_R2);
    float* SSM = (float*)(a.ws + WS_SSM); float* SSF = (float*)(a.ws + WS_SSF);
    const bf16* Win_t = (const bf16*)(a.ws + WS_WIN); const bf16* Wout_t = (const bf16*)(a.ws + WS_WOUT); const bf16* Wup_t = (const bf16*)(a.ws + WS_WUP); const bf16* Wdn_t = (const bf16*)(a.ws + WS_WDOWN);
    if constexpr (L < 0) {
        convert_weights(a, 0, 5, lds, gw, NGW, wave, lane);
        prologue_rows(a.in[0], a.in[1], XB, SSM, gw, NGW, lane);
    } else if constexpr (S == 0) {
        pg8::Gemm g{XB, Win_t, M, NINP, D}; PrefetchOrder So; So.init(M, NINP, G, (int)blockIdx.x); So.ssp = SSM; So.cw = nullptr; So.cb = nullptr; So.xl = lds + XL_OFF; So.tid = tid; So.cnt = 0; EpiIn E{Pb, lds + XL_OFF, 0};
        pg8::gemm_phase<EpiIn, PrefetchOrder, PG8_ALIGN, PG8_SP2>(lds, g, So, E, tid);
    } else if constexpr (S == 1) {
        for (int item = blockIdx.x; item < 512; item += G) mixer_a_item(a, L, item, lds, tid, wave, lane);
        xcd_arrive(xb, tid);
        for (int item = blockIdx.x; item < 512; item += G) mixer_gmlp_item(a, L, item, lds, tid, wave, lane);
        xcd_wait(xb, tid);
    } else if constexpr (S == 2) {
        mixer_scan(a, tid);
        xcd_arrive(xb, tid);
    } else if constexpr (S == 3) {
        for (int item = blockIdx.x; item < 512; item += G) mixer_gla_item(a, L, item, lds, tid, wave, lane, xb, item == (int)blockIdx.x);
        xcd_arrive(xb, tid);
        convert_weights(a, L, 2, lds, gw, NGW, wave, lane);
        xcd_wait(xb, tid);
    } else if constexpr (S == 4) {
        pg8::Gemm g{MIX, Wout_t, M, D, D}; pg8::StaticOrder So; So.init(M, D, G, (int)blockIdx.x); EpiRes16<false> E{XB, nullptr, SSF, nullptr, nullptr};
        pg8::gemm_phase<EpiRes16<false>, pg8::StaticOrder, false, PG8_SP2>(lds, g, So, E, tid);
    } else if constexpr (S == 5) {
        pg8::Gemm g{XB, Wup_t, M, NUP, D}; PrefetchOrder So; So.init(M, NUP, G, (int)blockIdx.x); So.ssp = SSF; So.cw = a.in[15] + (size_t)L * 3 * NUP; So.cb = a.in[16] + (size_t)L * NUP; So.xl = lds + XL_OFF; So.tid = tid; So.cnt = 0; EpiUpConv E{ACT, Yb, lds + XL_OFF, 0};
        pg8::gemm_phase<EpiUpConv, PrefetchOrder, PG8_ALIGN, PG8_SP2>(lds, g, So, E, tid);
        { constexpr int NU = (M / 256) * (NUP / 256); const int nfull = NU % G;
          if (L + 1 < DEPTH && (int)blockIdx.x >= nfull) convert_weights(a, L + 1, 1, lds, ((int)blockIdx.x - nfull) * 8 + wave, (G - nfull) * 8, wave, lane); }
        xcd_barrier(xb, tid);
    } else if constexpr (S == 6) {
        conv_fix(a, L, tid);
        if (L + 1 < DEPTH) { xcd_arrive(xb, tid); convert_weights(a, L + 1, 4, lds, gw, NGW, wave, lane); xcd_wait(xb, tid); }
        else xcd_barrier(xb, tid);
    } else if constexpr (S == 7) {
        pg8::Gemm g{ACT, Wdn_t, M, D, FF}; pg8::StaticOrder So; So.init(M, D, G, (int)blockIdx.x); EpiRes16<(L + 1 == DEPTH)> E{XB, a.out, SSM, a.in[18], (unsigned*)a.ws + CW_PCNT};
        pg8::gemm_phase<EpiRes16<(L + 1 == DEPTH)>, pg8::StaticOrder, false, PG8_SP2>(lds, g, So, E, tid);
    } else {
        final_rows(a.out, a.in[18], SSM, gw, NGW, lane);
    }
}
#define SEAM() do { const int t_ = wave_s * 64 + lane_id(); xcd_barrier(xb, t_); } while (0)
#define RUN(L, S) { constexpr int k_ = 1 + NPH_L * (L) + (S); if (ph_lo <= k_ && k_ < ph_hi) { phase_body<L, S>(lds, wave_s, xb); \
    if constexpr ((S) == 0 || (S) == 4 || (S) == 7) { if (k_ + 1 < ph_hi) SEAM(); } } }
#define RUN_LAYER(L) RUN(L, 0) RUN(L, 1) RUN(L, 2) RUN(L, 3) RUN(L, 4) RUN(L, 5) RUN(L, 6) RUN(L, 7)
__global__ void __launch_bounds__(NTHR, 2) mk_fwd(Args a) {
    extern __shared__ __attribute__((aligned(16))) unsigned char lds_raw[];
    LAS unsigned char* lds = (LAS unsigned char*)lds_raw;
    cg::grid_group grid = cg::this_grid();
    const int wave_s = __builtin_amdgcn_readfirstlane((int)(threadIdx.x >> 6));
    volatile LAS unsigned* MISC = (volatile LAS unsigned*)(lds + MISC_OFF);
    if (threadIdx.x < 4) MISC[threadIdx.x] = 0u;
    __syncthreads();
    const int ph_lo = kargs().ph_lo, ph_hi = kargs().ph_hi;
    XcdBarrier xb = xcd_barrier_post((unsigned*)kargs().ws + CW_BAR, MISC, (int)threadIdx.x);
    if (ph_lo <= 0 && 0 < ph_hi) {
        phase_body<-1, 0>(lds, wave_s, xb);
        if (ph_lo < -1) grid.sync();
        if (1 < ph_hi) SEAM();
    }
    RUN_LAYER(0)
    RUN_LAYER(1)
    RUN_LAYER(2)
    RUN_LAYER(3)
}

extern "C" void kernel_launch(void* const* d_in, const int* in_sizes, int n_in, void* d_out, int out_size, void* d_ws, size_t ws_size, hipStream_t stream) {
    static int grid = 0;
    if (grid == 0) {
        if (n_in != 19 || out_size != M * D || ws_size < WS_END) { fprintf(stderr, "kernel_launch: unexpected shapes / workspace (%d inputs, out %d, ws %zu)\n", n_in, out_size, ws_size); grid = -1; return; }
        int dev = 0, cus = 0, per_cu = 0;
        hipGetDevice(&dev); hipDeviceGetAttribute(&cus, hipDeviceAttributeMultiprocessorCount, dev);
        hipFuncSetAttribute((const void*)mk_fwd, hipFuncAttributeMaxDynamicSharedMemorySize, LDS_BYTES);
        hipOccupancyMaxActiveBlocksPerMultiprocessor(&per_cu, (const void*)mk_fwd, NTHR, LDS_BYTES);
        if (per_cu < 1) per_cu = 1;
        grid = cus * per_cu;
        if (grid != 256) { fprintf(stderr, "kernel_launch: built for a 256-workgroup grid (one per CU), got %d\n", grid); grid = -1; return; }
        (void)hipGetLastError();
    }
    if (grid < 0) return;
    if (hipMemsetAsync(d_ws, 0, CTL_ZERO_BYTES, stream) != hipSuccess) return;
    Args a{};
    for (int i = 0; i < 19; ++i) a.in[i] = (const float*)d_in[i];
    a.out = (float*)d_out; a.ws = (unsigned char*)d_ws;
#if MK_SINGLE
    a.ph_lo = 0; a.ph_hi = NPHASE;
    void* args[] = {&a};
    hipError_t e = hipLaunchCooperativeKernel((const void*)mk_fwd, dim3(grid), dim3(NTHR), args, LDS_BYTES, stream);
    if (e != hipSuccess) fprintf(stderr, "cooperative launch failed: %s (grid %d)\n", hipGetErrorString(e), grid);
#else
    for (int ph = 0; ph < NPHASE; ++ph) { a.ph_lo = ph; a.ph_hi = ph + 1; hipLaunchKernelGGL(mk_fwd, dim3(grid), dim3(NTHR), LDS_BYTES, stream, a); }
#endif
}
```

```cpp
#include <hip/hip_runtime.h>
#include <hip/hip_cooperative_groups.h>
#include <cstdio>
#include <cstdint>
namespace pg8 {
#define PG8_LAS __attribute__((address_space(3)))
typedef unsigned short bf16_t;
typedef short bf16x8 __attribute__((ext_vector_type(8)));
typedef float f32x4 __attribute__((ext_vector_type(4)));
typedef unsigned u32x4 __attribute__((ext_vector_type(4)));
constexpr int BM = 256, BK = 64, HALF = 128, HTB = HALF * BK * 2  , STAGE_BYTES = 8 * HTB, NXCD = 8, WGM = 8;

__host__ __device__ __forceinline__ int lds_byte(int r, int c) { const int st = (r >> 4) * 2 + (c >> 5), rr = r & 15, cc = c & 31, ob = rr * 64 + cc * 2; return st * 1024 + (ob ^ (((ob >> 9) & 1) << 5)); }
__host__ __device__ __forceinline__ void stage_rc(int b, int& R, int& C) { const int st = b / 1024, sb = b % 1024, swz = sb ^ (((sb >> 9) & 1) << 5); R = (st >> 1) * 16 + swz / 64; C = (st & 1) * 32 + (swz % 64) / 2; }
__host__ __device__ __forceinline__ int perm32(int rho) { const int n = rho >> 4, i = rho & 15; return 8 * (i >> 2) + 4 * n + (i & 3); }

struct Unit { int pm, pn; };
struct Gemm { const bf16_t* A; const bf16_t* Bt; int M, N, K; };

struct StaticOrder {
    int nM, nN, nwg, G, c;
    __host__ __device__ void init(int M, int N, int G_, int c_) { nM = M / BM; nN = N / BM; nwg = nM * nN; G = G_; c = c_; }
    __host__ __device__ bool next(int i, Unit& u) const {
        const long L = (long)i * G + c; if (L >= nwg) return false;
        int wgid = (int)L; { const int q = nwg / NXCD, r = nwg % NXCD, xcd = wgid % NXCD, off = wgid / NXCD; wgid = (xcd < r ? xcd * (q + 1) : r * (q + 1) + (xcd - r) * q) + off; }
        const int nig = WGM * nN, gid = wgid / nig, fm = gid * WGM, gsz = (nM - fm) < WGM ? (nM - fm) : WGM;
        u.pm = fm + ((wgid % nig) % gsz); u.pn = (wgid % nig) / gsz; return true;
    }
    __device__ __forceinline__ void a_ready(const Unit&) const {}
    __device__ __forceinline__ void done(const Unit&) const {}
};

__device__ __forceinline__ unsigned cvt_pk_bf16(float lo, float hi) { unsigned r; asm volatile("v_cvt_pk_bf16_f32 %0, %1, %2" : "=v"(r) : "v"(lo), "v"(hi)); return r; }
typedef float f32x2 __attribute__((ext_vector_type(2)));
__device__ __forceinline__ f32x2 gelu_pk(f32x2 v) {
    const f32x2 av = __builtin_elementwise_abs(v), d = av * 0.2316418882f + 1.0f;
    f32x2 t; t.x = __builtin_amdgcn_rcpf(d.x); t.y = __builtin_amdgcn_rcpf(d.y);
    f32x2 q = t * 0.5307027145f + (-0.7265760135f); q = q * t + 0.7107068705f; q = q * t + (-0.142248368f); q = q * t + 0.127414796f; q = q * t;
    const f32x2 s = (v * v) * (-0.72134752044f);
    f32x2 e; e.x = __builtin_amdgcn_exp2f(s.x); e.y = __builtin_amdgcn_exp2f(s.y);
    const f32x2 m = v * (q * e), r = v - m;
    f32x2 o; o.x = v.x < 0.f ? m.x : r.x; o.y = v.y < 0.f ? m.y : r.y; return o;
}

template <int ACT  > struct EpiBf16 {
    static constexpr bool PERM = true, AFTER_DRAIN = false; static_assert(ACT == 0 || ACT == 1, "EpiBf16: ACT is 0 (none) or 1 (gelu_pk)");
    bf16_t* O; int ldc; const float* bias; int split_cols; size_t split_stride; float scale0;
    __device__ __forceinline__ void operator()(const f32x4 (&acc)[2][2][4][2], const Unit& u, int wr, int wc, int fr, int fq) const {
        const int row0 = u.pm * BM + wr * 64 + fr; int colt = u.pn * BM; bf16_t* base = O;
        float sc = 1.f; if (split_cols) { const int t = colt / split_cols; base += (size_t)t * split_stride; colt -= t * split_cols; if (t == 0) sc = scale0; }
        const int col0 = colt + wc * 32 + 8 * fq, bcol0 = u.pn * BM + wc * 32 + 8 * fq;
        f32x4 bv[2][2];
#pragma unroll
        for (int bj = 0; bj < 2; ++bj)
#pragma unroll
            for (int n = 0; n < 2; ++n) bv[bj][n] = bias ? *(const f32x4*)(bias + bcol0 + bj * HALF + 4 * n) : (f32x4){0.f, 0.f, 0.f, 0.f};
#pragma unroll
        for (int ai = 0; ai < 2; ++ai)
#pragma unroll
            for (int m = 0; m < 4; ++m) { bf16_t* rowp = base + (size_t)(row0 + ai * HALF + m * 16) * ldc + col0;
#pragma unroll
                for (int bj = 0; bj < 2; ++bj) { f32x4 v0 = acc[ai][bj][m][0] + bv[bj][0], v1 = acc[ai][bj][m][1] + bv[bj][1];
                    if (ACT == 1) { f32x2 a = gelu_pk((f32x2){v0[0], v0[1]}), b = gelu_pk((f32x2){v0[2], v0[3]}), c = gelu_pk((f32x2){v1[0], v1[1]}), d = gelu_pk((f32x2){v1[2], v1[3]});
                        v0 = (f32x4){a.x, a.y, b.x, b.y}; v1 = (f32x4){c.x, c.y, d.x, d.y}; }
                    v0 = v0 * sc; v1 = v1 * sc; u32x4 w; w.x = cvt_pk_bf16(v0[0], v0[1]); w.y = cvt_pk_bf16(v0[2], v0[3]); w.z = cvt_pk_bf16(v1[0], v1[1]); w.w = cvt_pk_bf16(v1[2], v1[3]);
                    *(u32x4*)(rowp + bj * HALF) = w; } }
    }
};
template <class Epi, class Sched, bool ALIGN_EPI = false, bool SP2 = false>
__device__ __forceinline__ void gemm_phase(PG8_LAS unsigned char* lds, const Gemm g, const Sched& S, const Epi& E, const int tid) {
    const int wid = __builtin_amdgcn_readfirstlane(tid >> 6), lane = tid & 63, wr = wid >> 2, wc = wid & 3, fr = lane & 15, fq = lane >> 4;
    const int K = g.K, nt = K / BK;
    unsigned voffA[2], voffB[2];
#pragma unroll
    for (int i = 0; i < 2; ++i) { int R, C; stage_rc(tid * 16 + i * 8192, R, C); const int Rb = Epi::PERM ? ((R & ~31) + perm32(R & 31)) : R;
        const int Ra = Epi::APERM ? ((R & ~63) | ((R & 15) << 2) | ((R >> 4) & 3)) : R;
        voffA[i] = (unsigned)(Ra * K + C) * 2u; voffB[i] = (unsigned)(Rb * K + C) * 2u; }
    const size_t kstep = (size_t)(BK * 2);
    const size_t hstep = (size_t)HALF * K * 2;
    const size_t tstep = 2 * hstep;
    const unsigned ldsw = (unsigned)wid * 1024u;
    const int aoff = lds_byte(wr * 64 + fr, fq * 8), boff = lds_byte(wc * 32 + fr, fq * 8);
#define PG8_SA(b, h) (((b) * 2 + (h)) * HTB)
#define PG8_SB(b, h) ((4 + (b) * 2 + (h)) * HTB)
#define PG8_STAGE(bufoff, gbase, voff) do { _Pragma("unroll") for (int _i = 0; _i < 2; ++_i) \
        __builtin_amdgcn_global_load_lds((const unsigned*)((const char*)(gbase) + (voff)[_i]), (PG8_LAS unsigned*)(lds + (bufoff) + ldsw + _i * 8192), 16, 0, 0); } while (0)
#define PG8_LDA(dst, b, h) do { _Pragma("unroll") for (int m = 0; m < 4; ++m) _Pragma("unroll") for (int k = 0; k < 2; ++k) dst[m][k] = *(const PG8_LAS bf16x8*)(lds + PG8_SA(b, h) + aoff + m * 2048 + k * 1024); } while (0)
#define PG8_LDB(dst, b, h) do { _Pragma("unroll") for (int n = 0; n < 2; ++n) _Pragma("unroll") for (int k = 0; k < 2; ++k) dst[n][k] = *(const PG8_LAS bf16x8*)(lds + PG8_SB(b, h) + boff + n * 2048 + k * 1024); } while (0)
#define PG8_MMA(ai, bj, At, Bt) do { __builtin_amdgcn_s_setprio(1); _Pragma("unroll") for (int m = 0; m < 4; ++m) _Pragma("unroll") for (int n = 0; n < 2; ++n) _Pragma("unroll") for (int k = 0; k < 2; ++k) \
        acc[ai][bj][m][n] = __builtin_amdgcn_mfma_f32_16x16x32_bf16(Bt[n][k], At[m][k], acc[ai][bj][m][n], 0, 0, 0); __builtin_amdgcn_s_setprio(0); } while (0)
#define PG8_WAIT_V(n) asm volatile("s_waitcnt vmcnt(" #n ")" ::: "memory")
#define PG8_WAIT_L(n) asm volatile("s_waitcnt lgkmcnt(" #n ")" ::: "memory")
#define PG8_BAR __builtin_amdgcn_s_barrier()
#define PG8_SCHED __builtin_amdgcn_sched_barrier(0)
    Unit cur, nxt; int ui = 0;
    if (!S.next(0, cur)) return;
    f32x4 acc[2][2][4][2];
#pragma unroll
    for (int a = 0; a < 2; ++a)
#pragma unroll
        for (int b = 0; b < 2; ++b)
#pragma unroll
            for (int m = 0; m < 4; ++m)
#pragma unroll
                for (int n = 0; n < 2; ++n) acc[a][b][m][n] = (f32x4){0.f, 0.f, 0.f, 0.f};
    bf16x8 At[4][2], B0[2][2], B1[2][2];
    const char* cA = (const char*)g.A + (size_t)cur.pm * tstep; const char* cB = (const char*)g.Bt + (size_t)cur.pn * tstep;
    S.a_ready(cur);
    if constexpr (SP2) {
        PG8_STAGE(PG8_SB(0, 0), cB, voffB); PG8_STAGE(PG8_SB(0, 1), cB + hstep, voffB); PG8_STAGE(PG8_SA(0, 0), cA, voffA); PG8_STAGE(PG8_SA(0, 1), cA + hstep, voffA);
        if (wr == 1) PG8_BAR;
        PG8_WAIT_V(2); PG8_BAR;
        PG8_STAGE(PG8_SB(1, 0), cB + kstep, voffB); PG8_STAGE(PG8_SA(1, 0), cA + kstep, voffA); PG8_STAGE(PG8_SB(1, 1), cB + hstep + kstep, voffB);
        PG8_WAIT_V(6); PG8_BAR;
    } else {
        PG8_STAGE(PG8_SB(0, 0), cB, voffB); PG8_STAGE(PG8_SA(0, 0), cA, voffA); PG8_STAGE(PG8_SB(0, 1), cB + hstep, voffB); PG8_STAGE(PG8_SA(0, 1), cA + hstep, voffA);
        if (wr == 1) PG8_BAR;
        PG8_WAIT_V(4); PG8_BAR;
        PG8_STAGE(PG8_SB(1, 0), cB + kstep, voffB); PG8_STAGE(PG8_SA(1, 0), cA + kstep, voffA); PG8_STAGE(PG8_SB(1, 1), cB + hstep + kstep, voffB);
        PG8_WAIT_V(6); PG8_BAR;
    }
    for (;;) {
        const bool has_next = S.next(ui + 1, nxt);
        const char* nA = has_next ? (const char*)g.A + (size_t)nxt.pm * tstep : cA; const char* nB = has_next ? (const char*)g.Bt + (size_t)nxt.pn * tstep : cB;
        for (int t = 0; t < nt; t += 2) {
            const bool last = (t == nt - 2);
            const char* a1 = cA + (size_t)(t + 1) * kstep;
            const char* a2 = last ? nA : cA + (size_t)(t + 2) * kstep; const char* b2 = last ? nB : cB + (size_t)(t + 2) * kstep;
            const char* a3 = a2 + kstep; const char* b3 = b2 + kstep;
            if (last && has_next) S.a_ready(nxt);
            if constexpr (SP2) {
            PG8_LDB(B0, 0, 0); PG8_LDB(B1, 0, 1); PG8_SCHED; PG8_LDA(At, 0, 0); PG8_STAGE(PG8_SA(1, 1), a1 + hstep, voffA);
            PG8_WAIT_V(8); PG8_WAIT_L(0); PG8_BAR; PG8_MMA(0, 0, At, B0); PG8_MMA(0, 1, At, B1); PG8_BAR; PG8_SCHED;
            PG8_LDA(At, 0, 1); PG8_STAGE(PG8_SB(0, 0), b2, voffB); PG8_STAGE(PG8_SB(0, 1), b2 + hstep, voffB); PG8_STAGE(PG8_SA(0, 0), a2, voffA);
            PG8_WAIT_V(8); PG8_WAIT_L(0); PG8_BAR; PG8_MMA(1, 0, At, B0); PG8_MMA(1, 1, At, B1); PG8_BAR; PG8_SCHED;
            PG8_LDB(B0, 1, 0); PG8_LDB(B1, 1, 1); PG8_SCHED; PG8_LDA(At, 1, 0); PG8_STAGE(PG8_SA(0, 1), a2 + hstep, voffA);
            PG8_WAIT_V(8); PG8_WAIT_L(0); PG8_BAR; PG8_MMA(0, 0, At, B0); PG8_MMA(0, 1, At, B1); PG8_BAR; PG8_SCHED;
            PG8_LDA(At, 1, 1); PG8_STAGE(PG8_SB(1, 0), b3, voffB); PG8_STAGE(PG8_SB(1, 1), b3 + hstep, voffB); PG8_STAGE(PG8_SA(1, 0), a3, voffA);
            PG8_WAIT_V(8); PG8_WAIT_L(0); PG8_BAR; PG8_MMA(1, 0, At, B0); PG8_MMA(1, 1, At, B1); PG8_BAR; PG8_SCHED;
            } else {
            PG8_LDB(B0, 0, 0); PG8_SCHED; PG8_LDA(At, 0, 0); PG8_STAGE(PG8_SA(1, 1), a1 + hstep, voffA);
            PG8_WAIT_L(8); PG8_BAR; PG8_WAIT_L(0); PG8_MMA(0, 0, At, B0); PG8_BAR; PG8_SCHED;
            PG8_LDB(B1, 0, 1); PG8_STAGE(PG8_SB(0, 0), b2, voffB);
            PG8_BAR; PG8_WAIT_L(0); PG8_MMA(0, 1, At, B1); PG8_BAR;
            PG8_LDA(At, 0, 1); PG8_STAGE(PG8_SA(0, 0), a2, voffA);
            PG8_BAR; PG8_WAIT_L(0); PG8_MMA(1, 0, At, B0); PG8_BAR; PG8_SCHED;
            PG8_STAGE(PG8_SB(0, 1), b2 + hstep, voffB);
            PG8_WAIT_V(6); PG8_BAR; PG8_MMA(1, 1, At, B1); PG8_BAR;
            PG8_LDB(B0, 1, 0); PG8_SCHED; PG8_LDA(At, 1, 0); PG8_STAGE(PG8_SA(0, 1), a2 + hstep, voffA);
            PG8_WAIT_L(8); PG8_BAR; PG8_WAIT_L(0); PG8_MMA(0, 0, At, B0); PG8_BAR; PG8_SCHED;
            PG8_LDB(B1, 1, 1); PG8_STAGE(PG8_SB(1, 0), b3, voffB);
            PG8_BAR; PG8_WAIT_L(0); PG8_MMA(0, 1, At, B1); PG8_BAR;
            PG8_LDA(At, 1, 1); PG8_STAGE(PG8_SA(1, 0), a3, voffA);
            PG8_BAR; PG8_WAIT_L(0); PG8_MMA(1, 0, At, B0); PG8_BAR; PG8_SCHED;
            PG8_STAGE(PG8_SB(1, 1), b3 + hstep, voffB);
            PG8_WAIT_V(6); PG8_BAR; PG8_MMA(1, 1, At, B1); PG8_BAR;
            }
        }
        if constexpr (ALIGN_EPI) { if (wr == 0) PG8_BAR; }
        if constexpr (!Epi::AFTER_DRAIN) { E(acc, cur, wr, wc, fr, fq); S.done(cur); }
        if (!has_next) break;
#pragma unroll
        for (int a = 0; a < 2; ++a)
#pragma unroll
            for (int b = 0; b < 2; ++b)
#pragma unroll
                for (int m = 0; m < 4; ++m)
#pragma unroll
                    for (int n = 0; n < 2; ++n) acc[a][b][m][n] = (f32x4){0.f, 0.f, 0.f, 0.f};
        cur = nxt; cA = nA; cB = nB; ++ui;
        if constexpr (ALIGN_EPI) { if (wr == 1) PG8_BAR; }
    }
    PG8_WAIT_V(0);
    if constexpr (!ALIGN_EPI) { if (wr == 0) PG8_BAR; }
    PG8_BAR;
    if constexpr (Epi::AFTER_DRAIN) { E.fused(acc, cur, wr, wc, fr, fq, lds, wid, lane); S.done(cur); }
#undef PG8_SA
#undef PG8_SB
#undef PG8_STAGE
#undef PG8_LDA
#undef PG8_LDB
#undef PG8_MMA
#undef PG8_WAIT_V
#undef PG8_WAIT_L
#undef PG8_BAR
#undef PG8_SCHED
}
}
#define LAS __attribute__((address_space(3)))
#define XB_TMO      128
#define XB_XCNT(j)  (256  + 64 * (j))
#define XB_XSUB(j)  (1280 + 64 * (j))
#define XB_XGEN(j)  (2304 + 64 * (j))
#define XB_TOP      3328
#define XB_TOPGEN   3392
#define XCD_BAR_WORDS 3456
#define XB_SPIN_CAP (1u << 18)

__device__ __forceinline__ unsigned xb_ld(unsigned* p)              { return __hip_atomic_load(p, __ATOMIC_RELAXED, __HIP_MEMORY_SCOPE_AGENT); }
__device__ __forceinline__ unsigned xb_add(unsigned* p, unsigned v) { return __hip_atomic_fetch_add(p, v, __ATOMIC_RELAXED, __HIP_MEMORY_SCOPE_AGENT); }
__device__ __forceinline__ unsigned xb_xcc_id() { return (unsigned)__builtin_amdgcn_s_getreg((3 << 11) | 20) & 0xFu; }
#define XB_SPIN(cond, bar) do { unsigned _sp = 0; while (cond) { __builtin_amdgcn_s_sleep(1); \
    if ((++_sp & 255u) == 0u) { if (xb_ld(&(bar)[XB_TMO])) break; if (_sp > XB_SPIN_CAP) { atomicAdd(&(bar)[XB_TMO], 1u); break; } } } } while (0)

struct XcdBarrier {
    unsigned* bar; unsigned x;
    volatile LAS unsigned* st;
};

__device__ __forceinline__ XcdBarrier xcd_barrier_post(unsigned* bar, volatile LAS unsigned* st, const int tid) {
    XcdBarrier b; b.bar = bar; b.x = xb_xcc_id(); b.st = st;
    if (tid == 0) (void)xb_add(&bar[XB_XCNT(b.x)], 1u);
    return b;
}
__device__ __forceinline__ void xcd_barrier_complete(unsigned* bar, unsigned x, unsigned& nloc, unsigned& nx) {
    const unsigned G = gridDim.x * gridDim.y * gridDim.z;
    unsigned sum, cnt, mine, sp = 0u;
    for (;;) {
        sum = 0u; cnt = 0u; mine = 0u;
#pragma unroll
        for (unsigned j = 0; j < 16; ++j) { const unsigned c = xb_ld(&bar[XB_XCNT(j)]); sum += c; cnt += (c > 0u) ? 1u : 0u; mine = (j == x) ? c : mine; }
        if (sum == G) break;
        __builtin_amdgcn_s_sleep(1);
        if ((++sp & 255u) == 0u) { if (xb_ld(&bar[XB_TMO])) break; if (sp > XB_SPIN_CAP) { atomicAdd(&bar[XB_TMO], 1u); break; } }
    }
    nloc = mine > 0u ? mine : 1u; nx = cnt > 0u ? cnt : 1u;
}

__device__ __forceinline__ void xcd_barrier(const XcdBarrier& b, const int tid) {
    asm volatile("s_waitcnt vmcnt(0)" ::: "memory");
    __syncthreads();
    if (tid == 0) {
        unsigned* bar = b.bar;
        __builtin_amdgcn_s_waitcnt(0);
        unsigned nloc = b.st[0], nx = b.st[1];
        if (nloc == 0u) { xcd_barrier_complete(bar, b.x, nloc, nx); b.st[0] = nloc; b.st[1] = nx; }
        const unsigned old = xb_add(&bar[XB_XSUB(b.x)], 1u);
        const unsigned gen = old / nloc;
        if (old + 1u == (gen + 1u) * nloc) {
            __builtin_amdgcn_fence(__ATOMIC_RELEASE, "agent");
            asm volatile("s_waitcnt vmcnt(0)" ::: "memory");
            const unsigned og = xb_add(&bar[XB_TOP], 1u);
            const unsigned tg = og / nx;
            if (og + 1u == (tg + 1u) * nx) xb_add(&bar[XB_TOPGEN], 1u);
            else XB_SPIN(xb_ld(&bar[XB_TOPGEN]) == tg, bar);
            __builtin_amdgcn_fence(__ATOMIC_ACQUIRE, "agent");
            xb_add(&bar[XB_XGEN(b.x)], 1u);
            asm volatile("s_waitcnt vmcnt(0)" ::: "memory");
        } else {
            XB_SPIN(xb_ld(&bar[XB_XGEN(b.x)]) == gen, bar);
            __builtin_amdgcn_fence(__ATOMIC_ACQUIRE, "agent");
            asm volatile("s_waitcnt vmcnt(0)" ::: "memory");
        }
    }
    __syncthreads();
}
#ifndef PG8_SP2
#define PG8_SP2 true
#endif
#ifndef PG8_ALIGN
#define PG8_ALIGN true
#endif
#ifndef NLAYERS
#define NLAYERS 4
#endif
#ifndef MK_SINGLE
#define MK_SINGLE 1
#endif
namespace cg = cooperative_groups;
#define LAS __attribute__((address_space(3)))
typedef unsigned short bf16;
typedef float f32x4 __attribute__((ext_vector_type(4)));
typedef float f32x2 __attribute__((ext_vector_type(2)));
typedef short bf16x8 __attribute__((ext_vector_type(8)));
typedef unsigned u32x4 __attribute__((ext_vector_type(4)));
typedef unsigned u32x2 __attribute__((ext_vector_type(2)));

__device__ __forceinline__ void xcd_arrive(const XcdBarrier& b, const int tid) {
    asm volatile("s_waitcnt vmcnt(0)" ::: "memory");
    __syncthreads();
    if (tid == 0) {
        unsigned* bar = b.bar;
        __builtin_amdgcn_s_waitcnt(0);
        unsigned nloc = b.st[0], nx = b.st[1];
        if (nloc == 0u) { xcd_barrier_complete(bar, b.x, nloc, nx); b.st[0] = nloc; b.st[1] = nx; }
        const unsigned old = xb_add(&bar[XB_XSUB(b.x)], 1u);
        const unsigned gen = old / nloc;
        b.st[2] = gen;
        if (old + 1u == (gen + 1u) * nloc) {
            __builtin_amdgcn_fence(__ATOMIC_RELEASE, "agent");
            asm volatile("s_waitcnt vmcnt(0)" ::: "memory");
            (void)xb_add(&bar[XB_XGEN(b.x)], 1u);
            asm volatile("s_waitcnt vmcnt(0)" ::: "memory");
            const unsigned og = xb_add(&bar[XB_TOP], 1u);
            const unsigned tg = og / nx;
            if (og + 1u == (tg + 1u) * nx) xb_add(&bar[XB_TOPGEN], 1u);
        }
    }
    __syncthreads();
}
__device__ __forceinline__ void xcd_wait(const XcdBarrier& b, const int tid) {
    __syncthreads();
    if (tid == 0) {
        unsigned* bar = b.bar;
        const unsigned gen = b.st[2];
        XB_SPIN(xb_ld(&bar[XB_TOPGEN]) <= gen, bar);
        __builtin_amdgcn_fence(__ATOMIC_ACQUIRE, "agent");
        asm volatile("s_waitcnt vmcnt(0)" ::: "memory");
    }
    __syncthreads();
}
constexpr int NTHR = 512;
constexpr int BATCH = 2, SEQ = 8192, D = 1024, M = BATCH * SEQ, DEPTH = 4;
constexpr int NIN = 2592, NINP = 2816, FF = 2816, NUP = 5632;
constexpr float EPS = 1e-6f;
constexpr int NPHASE = 1 + 8 * DEPTH;
constexpr size_t MiB = 1u << 20;
constexpr size_t WS_WIN = 2 * MiB, WS_WOUT = 8 * MiB, WS_WUP = 10 * MiB, WS_WDOWN = 21 * MiB;
constexpr size_t WS_R1 = 28 * MiB;
constexpr size_t WS_P = WS_R1, WS_MIX = WS_R1 + 88 * MiB, WS_DS = WS_R1 + 120 * MiB, WS_ST = WS_R1 + 152 * MiB, WS_DEC = WS_R1 + 168 * MiB;
constexpr size_t WS_R2 = 204 * MiB;
constexpr size_t WS_CUM = WS_R2;
constexpr size_t WS_XB = 292 * MiB;
constexpr size_t WS_END = 324 * MiB;
constexpr size_t WS_SSM = 1024 * 1024, WS_SSF = WS_SSM + 256 * 1024;
constexpr size_t WS_XN2 = WS_MIX;
constexpr int LDS_BYTES = 131072 + 16384 + 64, MISC_OFF = LDS_BYTES - 64, XL_OFF = 131072;
constexpr int CW_PCNT = 8192;
constexpr int CW_BAR = 4096;
constexpr size_t CTL_ZERO_BYTES = 65536;
constexpr int LDT = 136, LDK = 72;
constexpr int MB0 = 0, MB1 = 34816, MB2 = 69632, MB3 = 104448;
constexpr int RBUF_OFF = MB1, TOT_OFF = MB1 + 16384;

struct Args { const float* in[19]; float* out; unsigned char* ws; int ph_lo, ph_hi; };

__device__ __forceinline__ unsigned pk2(float lo, float hi) { return pg8::cvt_pk_bf16(lo, hi); }
__device__ __forceinline__ float bf_lo(unsigned u) { return __uint_as_float(u << 16); }
__device__ __forceinline__ float bf_hi(unsigned u) { return __uint_as_float(u & 0xffff0000u); }
__device__ __forceinline__ unsigned f2bf(float f) { unsigned u = __float_as_uint(f); return (u + 0x7fffu + ((u >> 16) & 1u)) >> 16; }
__device__ __forceinline__ float wave_sum(float v) {
#pragma unroll
    for (int o = 1; o < 64; o <<= 1) v += __shfl_xor(v, o);
    return v;
}
template <int CTRL, int ROWMASK, bool BC> __device__ __forceinline__ float dpp_add(float v) { return v + __int_as_float(__builtin_amdgcn_update_dpp(0, __float_as_int(v), CTRL, ROWMASK, 0xf, BC)); }
__device__ __forceinline__ float wave_sum_dpp(float v) {
    v = dpp_add<0x111, 0xf, true>(v); v = dpp_add<0x112, 0xf, true>(v); v = dpp_add<0x114, 0xf, true>(v); v = dpp_add<0x118, 0xf, true>(v);
    v = dpp_add<0x142, 0xa, false>(v); v = dpp_add<0x143, 0xc, false>(v);
    return __int_as_float(__builtin_amdgcn_readlane(__float_as_int(v), 63));
}
__device__ __forceinline__ float silu_f(float x) { return x * __frcp_rn(1.f + __expf(-x)); }
__device__ __forceinline__ f32x4 silu4(f32x4 x) {
    const f32x4 a = x * (-1.44269504089f);
    f32x4 e; e[0] = __builtin_amdgcn_exp2f(a[0]); e[1] = __builtin_amdgcn_exp2f(a[1]); e[2] = __builtin_amdgcn_exp2f(a[2]); e[3] = __builtin_amdgcn_exp2f(a[3]);
    const f32x4 d = e + 1.f;
    f32x4 r; r[0] = __builtin_amdgcn_rcpf(d[0]); r[1] = __builtin_amdgcn_rcpf(d[1]); r[2] = __builtin_amdgcn_rcpf(d[2]); r[3] = __builtin_amdgcn_rcpf(d[3]);
    return x * r;
}
__device__ __forceinline__ f32x2 logsig2_log2_16(f32x2 x) {
    const f32x2 a = __builtin_elementwise_abs(x) * (-1.44269504089f);
    f32x2 e; e.x = __builtin_amdgcn_exp2f(a.x); e.y = __builtin_amdgcn_exp2f(a.y);
    const f32x2 d = e + 1.f;
    f32x2 lg; lg.x = __builtin_amdgcn_logf(d.x); lg.y = __builtin_amdgcn_logf(d.y);
    return __builtin_elementwise_min(x, (f32x2){0.f, 0.f}) * (0.0625f * 1.44269504089f) - lg * 0.0625f;
}
__device__ __forceinline__ float logsig_f(float x) { return fminf(x, 0.f) - __logf(1.f + __expf(-fabsf(x))); }

__device__ __forceinline__ float lds_rstd(const LAS unsigned char* slot, int rowlocal) { const f32x4 p = *(const LAS f32x4*)(slot + 4096 + rowlocal * 16); return rsqrtf(((p[0] + p[1]) + (p[2] + p[3])) * (1.f / D) + EPS); }
__device__ __forceinline__ float row_rstd(const float* ssp, int row) { const f32x4 p = *(const f32x4*)(ssp + (size_t)row * 4); return rsqrtf(((p[0] + p[1]) + (p[2] + p[3])) * (1.f / D) + EPS); }
struct EpiIn {
    static constexpr bool PERM = true, AFTER_DRAIN = false, APERM = false;
    bf16* O; LAS unsigned char* xl; mutable int cnt;
    __device__ __forceinline__ void operator()(const f32x4 (&acc)[2][2][4][2], const pg8::Unit& u, int wr, int wc, int fr, int fq) const {
        const int row0 = u.pm * 256 + wr * 64 + fr, col0 = u.pn * 256 + wc * 32 + 8 * fq;
        const LAS unsigned char* slot = xl + (cnt & 1) * 8192; ++cnt;
        if (u.pn * 256 + wc * 32 >= NIN) return;
        const bool act = u.pn < 4; const float sc = (u.pn == 4) ? 0.125f : 1.f;
        float rsa[2][4];
#pragma unroll
        for (int ai = 0; ai < 2; ++ai)
#pragma unroll
            for (int m = 0; m < 4; ++m) rsa[ai][m] = lds_rstd(slot, ai * 128 + wr * 64 + m * 16 + fr);
#pragma unroll
        for (int ai = 0; ai < 2; ++ai)
#pragma unroll
            for (int m = 0; m < 4; ++m) { const int row = row0 + ai * 128 + m * 16; bf16* rowp = O + (size_t)row * NINP + col0;
                const float rs = rsa[ai][m];
#pragma unroll
                for (int bj = 0; bj < 2; ++bj) { f32x4 v0 = acc[ai][bj][m][0] * rs, v1 = acc[ai][bj][m][1] * rs;
                    if (act) { f32x2 a = pg8::gelu_pk((f32x2){v0[0], v0[1]}), b = pg8::gelu_pk((f32x2){v0[2], v0[3]}), c = pg8::gelu_pk((f32x2){v1[0], v1[1]}), d = pg8::gelu_pk((f32x2){v1[2], v1[3]});
                        v0 = (f32x4){a.x, a.y, b.x, b.y}; v1 = (f32x4){c.x, c.y, d.x, d.y}; }
                    v0 = v0 * sc; v1 = v1 * sc; u32x4 w; w.x = pk2(v0[0], v0[1]); w.y = pk2(v0[2], v0[3]); w.z = pk2(v1[0], v1[1]); w.w = pk2(v1[2], v1[3]);
                    *(u32x4*)(rowp + bj * 128) = w; } }
    }
};
struct EpiUp {
    static constexpr bool PERM = true, AFTER_DRAIN = false;
    bf16* O; const float* ss;
    __device__ __forceinline__ void operator()(const f32x4 (&acc)[2][2][4][2], const pg8::Unit& u, int wr, int wc, int fr, int fq) const {
        const int row0 = u.pm * 256 + wr * 64 + fr, col0 = u.pn * 256 + wc * 32 + 8 * fq;
#pragma unroll
        for (int ai = 0; ai < 2; ++ai)
#pragma unroll
            for (int m = 0; m < 4; ++m) { const int row = row0 + ai * 128 + m * 16; bf16* rowp = O + (size_t)row * NUP + col0;
                const float rs = row_rstd(ss, row);
#pragma unroll
                for (int bj = 0; bj < 2; ++bj) { const f32x4 v0 = acc[ai][bj][m][0] * rs, v1 = acc[ai][bj][m][1] * rs;
                    u32x4 w; w.x = pk2(v0[0], v0[1]); w.y = pk2(v0[2], v0[3]); w.z = pk2(v1[0], v1[1]); w.w = pk2(v1[2], v1[3]);
                    *(u32x4*)(rowp + bj * 128) = w; } }
    }
};
template <bool LAST>
struct EpiRes16 {
    static constexpr bool PERM = true, AFTER_DRAIN = true, APERM = false;
    bf16* xb; float* out; float* ssp; const float* gfin; unsigned* pcnt;
    __device__ __forceinline__ void fused(f32x4 (&acc)[2][2][4][2], const pg8::Unit& u, int wr, int wc, int fr, int fq, PG8_LAS unsigned char* lds, int wid, int lane) const {
        const int row0 = u.pm * 256 + wr * 64 + fr, col0 = u.pn * 256 + wc * 32 + 8 * fq;
        PG8_LAS float* part = (PG8_LAS float*)lds;
        PG8_LAS float* rtab = (PG8_LAS float*)(lds + 4096);
        u32x4 xva[2][4][2];
#pragma unroll
        for (int ai = 0; ai < 2; ++ai)
#pragma unroll
            for (int m = 0; m < 4; ++m)
#pragma unroll
                for (int bj = 0; bj < 2; ++bj) xva[ai][m][bj] = *(const u32x4*)(xb + (size_t)(row0 + ai * 128 + m * 16) * D + col0 + bj * 128);
        f32x4 gq[2][2];
        if (LAST) {
#pragma unroll
            for (int bj = 0; bj < 2; ++bj) { gq[bj][0] = *(const f32x4*)(gfin + col0 + bj * 128); gq[bj][1] = *(const f32x4*)(gfin + col0 + bj * 128 + 4); } }
#pragma unroll
        for (int ai = 0; ai < 2; ++ai)
#pragma unroll
            for (int m = 0; m < 4; ++m) { const int row = row0 + ai * 128 + m * 16; const size_t off = (size_t)row * D + col0; float sq = 0.f;
#pragma unroll
                for (int bj = 0; bj < 2; ++bj) { const u32x4 xv = xva[ai][m][bj];
                    const f32x4 x0 = (f32x4){bf_lo(xv.x), bf_hi(xv.x), bf_lo(xv.y), bf_hi(xv.y)} + acc[ai][bj][m][0], x1 = (f32x4){bf_lo(xv.z), bf_hi(xv.z), bf_lo(xv.w), bf_hi(xv.w)} + acc[ai][bj][m][1];
                    sq += ((x0[0] * x0[0] + x0[1] * x0[1]) + (x0[2] * x0[2] + x0[3] * x0[3])) + ((x1[0] * x1[0] + x1[1] * x1[1]) + (x1[2] * x1[2] + x1[3] * x1[3]));
                    if (LAST) { acc[ai][bj][m][0] = x0; acc[ai][bj][m][1] = x1; }
                    else *(u32x4*)(xb + off + bj * 128) = (u32x4){pk2(x0[0], x0[1]), pk2(x0[2], x0[3]), pk2(x1[0], x1[1]), pk2(x1[2], x1[3])}; }
                sq += __shfl_xor(sq, 16); sq += __shfl_xor(sq, 32);
                if (fq == 0) part[(ai * 128 + wr * 64 + m * 16 + fr) * 4 + wc] = sq; }
        asm volatile("s_waitcnt lgkmcnt(0)" ::: "memory"); __builtin_amdgcn_s_barrier(); asm volatile("" ::: "memory");
        const int t = wid * 64 + lane;
        float own = 0.f;
        if (t < 256) { const f32x4 p = *(const PG8_LAS f32x4*)(part + t * 4); own = (p[0] + p[1]) + (p[2] + p[3]); }
        if (!LAST) { if (t < 256) ssp[(size_t)(u.pm * 256 + t) * 4 + u.pn] = own; }
        else {
            if (t < 256) __hip_atomic_store(ssp + (size_t)(u.pm * 256 + t) * 4 + u.pn, own, __ATOMIC_RELAXED, __HIP_MEMORY_SCOPE_AGENT);
            asm volatile("s_waitcnt vmcnt(0)" ::: "memory");
            if (wid < 4 && lane == 0) __hip_atomic_fetch_add(pcnt + 64 * u.pm, 1u, __ATOMIC_RELAXED, __HIP_MEMORY_SCOPE_AGENT);
            if (wid == 0) {
                for (unsigned sp = 0; sp < (1u << 20); ++sp) {
                    if ((unsigned)__builtin_amdgcn_readfirstlane((int)__hip_atomic_load(pcnt + 64 * u.pm, __ATOMIC_RELAXED, __HIP_MEMORY_SCOPE_AGENT)) >= 16u) break;
                    __builtin_amdgcn_s_sleep(2);
                }
                __builtin_amdgcn_fence(__ATOMIC_ACQUIRE, "agent");
            }
            asm volatile("s_waitcnt vmcnt(0) lgkmcnt(0)" ::: "memory"); __builtin_amdgcn_s_barrier(); asm volatile("" ::: "memory");
            if (t < 256) { const float* sp4 = ssp + (size_t)(u.pm * 256 + t) * 4; float q4[4];
#pragma unroll
                for (int k = 0; k < 4; ++k) q4[k] = __hip_atomic_load(sp4 + k, __ATOMIC_RELAXED, __HIP_MEMORY_SCOPE_AGENT);
                rtab[t] = rsqrtf(((q4[0] + q4[1]) + (q4[2] + q4[3])) * (1.f / D) + EPS); }
            asm volatile("s_waitcnt vmcnt(0) lgkmcnt(0)" ::: "memory"); __builtin_amdgcn_s_barrier(); asm volatile("" ::: "memory");
#pragma unroll
            for (int ai = 0; ai < 2; ++ai)
#pragma unroll
                for (int m = 0; m < 4; ++m) { const float rs = rtab[ai * 128 + wr * 64 + m * 16 + fr]; const size_t off = (size_t)(row0 + ai * 128 + m * 16) * D + col0;
#pragma unroll
                    for (int bj = 0; bj < 2; ++bj) { *(f32x4*)(out + off + bj * 128) = acc[ai][bj][m][0] * rs * gq[bj][0]; *(f32x4*)(out + off + bj * 128 + 4) = acc[ai][bj][m][1] * rs * gq[bj][1]; } }
        }
    }
};

struct PrefetchOrder : pg8::StaticOrder {
    const float* ssp; const float* cw; const float* cb; LAS unsigned char* xl; int tid; mutable int cnt;
    __device__ __forceinline__ void a_ready(const pg8::Unit& u) const {
        LAS unsigned char* dst = xl + (cnt & 1) * 8192; ++cnt;
        const int wv = __builtin_amdgcn_readfirstlane(tid >> 6), ln = tid & 63;
        if (wv < 4) {
            if (cw) { const int run = 2 * wv + (ln >> 5), k = run & 3, half = run >> 2;
                const float* src = (k < 3 ? cw + (size_t)k * NUP : cb) + half * FF + u.pn * 128 + (ln & 31) * 4;
                __builtin_amdgcn_global_load_lds((const unsigned*)src, (LAS unsigned*)(dst + wv * 1024), 16, 0, 0); }
        } else {
            const float* src = ssp + (size_t)(u.pm * 256 + (wv - 4) * 64 + ln) * 4;
            __builtin_amdgcn_global_load_lds((const unsigned*)src, (LAS unsigned*)(dst + 4096 + (wv - 4) * 1024), 16, 0, 0);
        }
    }
};
constexpr int DPP_SHR1 = 0x111, DPP_SHL1 = 0x101, DPP_ROR1 = 0x121, DPP_ROR15 = 0x12F;
template <int CTRL> __device__ __forceinline__ float dpp0(float v) { return __int_as_float(__builtin_amdgcn_update_dpp(0, __float_as_int(v), CTRL, 0xf, 0xf, true)); }
__device__ __forceinline__ float dpp_prev(float cur, float grp_below) {
    const int t = __builtin_amdgcn_update_dpp(0, __float_as_int(grp_below), DPP_ROR1, 0xf, 0xf, false);
    return __int_as_float(__builtin_amdgcn_update_dpp(t, __float_as_int(cur), DPP_SHR1, 0xf, 0xf, false)); }
__device__ __forceinline__ float dpp_next(float cur, float grp_above) {
    const int t = __builtin_amdgcn_update_dpp(0, __float_as_int(grp_above), DPP_ROR15, 0xf, 0xf, false);
    return __int_as_float(__builtin_amdgcn_update_dpp(t, __float_as_int(cur), DPP_SHL1, 0xf, 0xf, false)); }
struct EpiUpConv {
    static constexpr bool PERM = false, AFTER_DRAIN = false, APERM = true;
    bf16* ACT; bf16* YB; LAS unsigned char* xl; mutable int cnt;
    __device__ __forceinline__ void operator()(const f32x4 (&acc)[2][2][4][2], const pg8::Unit& u, int wr, int wc, int fr, int fq) const {
        const int cg0 = wc * 32 + 4 * fq, jg0 = u.pn * 128 + cg0;
        const LAS unsigned char* slot = xl + (cnt & 1) * 8192; ++cnt;
        float rs[2][4];
#pragma unroll
        for (int ai = 0; ai < 2; ++ai)
#pragma unroll
            for (int m = 0; m < 4; ++m) rs[ai][m] = lds_rstd(slot, ai * 128 + wr * 64 + 4 * fr + m);
#pragma unroll
        for (int n = 0; n < 2; ++n) {
            const int jg = jg0 + 16 * n;
            const LAS unsigned char* wl = slot + (cg0 + 16 * n) * 4;
            const f32x4 wg0 = *(const LAS f32x4*)(wl), wg1 = *(const LAS f32x4*)(wl + 512), wg2 = *(const LAS f32x4*)(wl + 1024), bg = *(const LAS f32x4*)(wl + 1536);
            const f32x4 wv0 = *(const LAS f32x4*)(wl + 2048), wv1 = *(const LAS f32x4*)(wl + 2560), wv2 = *(const LAS f32x4*)(wl + 3072), bv = *(const LAS f32x4*)(wl + 3584);
#pragma unroll
            for (int ai = 0; ai < 2; ++ai) {
                f32x4 Gv[4], Vv[4];
#pragma unroll
                for (int m = 0; m < 4; ++m) { Gv[m] = acc[ai][0][m][n] * rs[ai][m]; Vv[m] = acc[ai][1][m][n] * rs[ai][m]; }
                const int blk = u.pm * 4 + ai * 2 + wr;
                bf16* ybp = YB + (size_t)(blk * 4) * NUP + u.pn * 256 + cg0 + 16 * n;
                if (fr == 0) {
#pragma unroll
                    for (int q = 0; q < 2; ++q) { bf16* p = ybp + (size_t)q * NUP; *(u32x2*)p = (u32x2){pk2(Gv[q][0], Gv[q][1]), pk2(Gv[q][2], Gv[q][3])}; *(u32x2*)(p + 128) = (u32x2){pk2(Vv[q][0], Vv[q][1]), pk2(Vv[q][2], Vv[q][3])}; } }
                if (fr == 15) {
#pragma unroll
                    for (int q = 2; q < 4; ++q) { bf16* p = ybp + (size_t)q * NUP; *(u32x2*)p = (u32x2){pk2(Gv[q][0], Gv[q][1]), pk2(Gv[q][2], Gv[q][3])}; *(u32x2*)(p + 128) = (u32x2){pk2(Vv[q][0], Vv[q][1]), pk2(Vv[q][2], Vv[q][3])}; } }
                f32x4 gpre, gnxt, vpre, vnxt;
#pragma unroll
                for (int c = 0; c < 4; ++c) { gpre[c] = dpp0<DPP_SHR1>(Gv[3][c]); gnxt[c] = dpp0<DPP_SHL1>(Gv[0][c]); vpre[c] = dpp0<DPP_SHR1>(Vv[3][c]); vnxt[c] = dpp0<DPP_SHL1>(Vv[0][c]); }
#pragma unroll
                for (int m = 0; m < 4; ++m) {
                    const f32x4 gp = m > 0 ? Gv[m > 0 ? m - 1 : 0] : gpre, gn = m < 3 ? Gv[m < 3 ? m + 1 : 3] : gnxt;
                    const f32x4 vp = m > 0 ? Vv[m > 0 ? m - 1 : 0] : vpre, vn = m < 3 ? Vv[m < 3 ? m + 1 : 3] : vnxt;
                    const f32x4 zg = bg + gp * wg0 + Gv[m] * wg1 + gn * wg2;
                    const f32x4 zv = bv + vp * wv0 + Vv[m] * wv1 + vn * wv2;
                    const f32x4 ov4 = silu4(zg) * zv; const float o0 = ov4[0], o1 = ov4[1], o2 = ov4[2], o3 = ov4[3];
                    const int row = u.pm * 256 + ai * 128 + wr * 64 + 4 * fr + m;
                    *(u32x2*)(ACT + (size_t)row * FF + jg) = (u32x2){pk2(o0, o1), pk2(o2, o3)};
                }
            }
        }
    }
};
__device__ __forceinline__ void transpose_item(const float* W, int K, int N, bf16* WT, LAS float* scr, int item, int lane, const float* gk = nullptr, const bool up_perm = false) {
    const int nblk = N / 32, kb = item / nblk, nb = item % nblk, k0 = 64 * kb, n0 = 32 * nb;
    const int r0 = !up_perm ? n0 : (n0 < FF ? 256 * (n0 >> 7) + (n0 & 127) : 256 * ((n0 - FF) >> 7) + 128 + ((n0 - FF) & 127));
    {
        const int rr = lane >> 3, c4 = (lane & 7) * 4;
        f32x4 v[8]; float gs[8];
#pragma unroll
        for (int i = 0; i < 8; ++i) { v[i] = *(const f32x4*)(W + (size_t)(k0 + rr + 8 * i) * N + n0 + c4); gs[i] = gk ? gk[k0 + rr + 8 * i] : 1.f; }
#pragma unroll
        for (int i = 0; i < 8; ++i) { LAS float* d = scr + (rr + 8 * i) * 33 + c4; d[0] = v[i][0] * gs[i]; d[1] = v[i][1] * gs[i]; d[2] = v[i][2] * gs[i]; d[3] = v[i][3] * gs[i]; }
    }
    asm volatile("s_waitcnt lgkmcnt(0)" ::: "memory");
    const int c = lane & 7;
#pragma unroll
    for (int j = 0; j < 4; ++j) { const int n = (lane >> 3) + 8 * j; const LAS float* s = scr + (8 * c) * 33 + n;
        u32x4 o; o.x = pk2(s[0 * 33], s[1 * 33]); o.y = pk2(s[2 * 33], s[3 * 33]); o.z = pk2(s[4 * 33], s[5 * 33]); o.w = pk2(s[6 * 33], s[7 * 33]);
        *(u32x4*)(WT + (size_t)(r0 + n) * K + k0 + 8 * c) = o; }
    asm volatile("s_waitcnt lgkmcnt(0)" ::: "memory");
}
__device__ __forceinline__ void convert_weights(const Args& a, int l, int which, LAS unsigned char* lds, int gw, int NGW, int wave, int lane) {
    LAS float* scr = (LAS float*)(lds + wave * 16384);
    const float* Win = a.in[2] + (size_t)l * D * NIN; const float* Wout = a.in[12] + (size_t)l * D * D;
    const float* Wup = a.in[14] + (size_t)l * D * NUP; const float* Wdn = a.in[17] + (size_t)l * FF * D;
    bf16* Win_t = (bf16*)(a.ws + WS_WIN); bf16* Wout_t = (bf16*)(a.ws + WS_WOUT); bf16* Wup_t = (bf16*)(a.ws + WS_WUP); bf16* Wdn_t = (bf16*)(a.ws + WS_WDOWN);
    constexpr int I_IN = (D / 64) * (NIN / 32), I_OUT = (D / 64) * (D / 32), I_UP = (D / 64) * (NUP / 32), I_DN = (FF / 64) * (D / 32);
    if (which & 1) {
        for (int it = gw; it < I_IN + I_OUT; it += NGW) {
            if (it < I_IN) transpose_item(Win, D, NIN, Win_t, scr, it, lane, a.in[1] + (size_t)l * D);
            else transpose_item(Wout, D, D, Wout_t, scr, it - I_IN, lane);
        }
        u32x4* pad = (u32x4*)(Win_t + (size_t)NIN * D);
        for (int i = gw * 64 + lane; i < (NINP - NIN) * D / 8; i += NGW * 64) pad[i] = (u32x4){0u, 0u, 0u, 0u};
    }
    if (which & 4) for (int it = gw; it < I_UP; it += NGW) transpose_item(Wup, D, NUP, Wup_t, scr, it, lane, a.in[13] + (size_t)l * D, true);
    if (which & 2) for (int it = gw; it < I_DN; it += NGW) transpose_item(Wdn, FF, D, Wdn_t, scr, it, lane);
}
__device__ __forceinline__ void prologue_rows(const float* X, const float* g, bf16* XN, float* ss, int gw, int NGW, int lane) {
    f32x4 gv[4];
#pragma unroll
    for (int j = 0; j < 4; ++j) gv[j] = ((const f32x4*)g)[lane + 64 * j];
    for (int m = gw; m < M; m += NGW) {
        const f32x4* xr = (const f32x4*)(X + (size_t)m * D) + lane; f32x4 v[4]; float s = 0.f;
#pragma unroll
        for (int j = 0; j < 4; ++j) { v[j] = xr[64 * j]; s += (v[j].x * v[j].x + v[j].y * v[j].y) + (v[j].z * v[j].z + v[j].w * v[j].w); }
        s = wave_sum(s);
        if (lane == 0) *(f32x4*)(ss + (size_t)m * 4) = (f32x4){s, 0.f, 0.f, 0.f};
        unsigned long long* o8 = (unsigned long long*)(XN + (size_t)m * D) + lane;
#pragma unroll
        for (int j = 0; j < 4; ++j) { const f32x4 y = v[j]; o8[64 * j] = (unsigned long long)pk2(y.x, y.y) | ((unsigned long long)pk2(y.z, y.w) << 32); }
    }
}
__device__ __forceinline__ void final_rows(float* X, const float* g, const float* ss, int gw, int NGW, int lane) {
    f32x4 gv[4];
#pragma unroll
    for (int j = 0; j < 4; ++j) gv[j] = ((const f32x4*)g)[lane + 64 * j];
    for (int m = gw; m < M; m += NGW) {
        f32x4* xr = (f32x4*)(X + (size_t)m * D) + lane; const float rstd = row_rstd(ss, m);
#pragma unroll
        for (int j = 0; j < 4; ++j) xr[64 * j] = xr[64 * j] * rstd * gv[j];
    }
}
#define LBAR() do { asm volatile("s_waitcnt lgkmcnt(0)" ::: "memory"); __builtin_amdgcn_s_barrier(); asm volatile("" ::: "memory"); } while (0)
template <int NT, int KS>
__device__ __forceinline__ void mma_rc(const LAS bf16* X, int ldx, int r0, const LAS bf16* Y, int ldy, int c0, f32x4 (&acc)[NT], int lane) {
    const int fr = lane & 15, fq = lane >> 4;
    const LAS bf16* yp = Y + (c0 + fr) * ldy + fq * 8;
    const LAS bf16* xp = X + (r0 + fr) * ldx + fq * 8;
#pragma unroll
    for (int ks = 0; ks < KS; ++ks) {
        const bf16x8 b = *(const LAS bf16x8*)(yp + ks * 32);
#pragma unroll
        for (int t = 0; t < NT; ++t) {
            const bf16x8 a = *(const LAS bf16x8*)(xp + t * 16 * ldx + ks * 32);
            acc[t] = __builtin_amdgcn_mfma_f32_16x16x32_bf16(a, b, acc[t], 0, 0, 0);
        }
    }
}
__device__ __forceinline__ void stage_rbuf(const bf16* P, int row0, LAS unsigned char* lds, int tid) {
    const int r = tid >> 2, part = tid & 3;
    const u32x4 v = *(const u32x4*)(P + (size_t)(row0 + r) * NINP + 2560 + part * 8);
    LAS f32x4* dst = (LAS f32x4*)(lds + RBUF_OFF + (r * 32 + part * 8) * 4);
    dst[0] = (f32x4){bf_lo(v.x), bf_hi(v.x), bf_lo(v.y), bf_hi(v.y)};
    dst[1] = (f32x4){bf_lo(v.z), bf_hi(v.z), bf_lo(v.w), bf_hi(v.w)};
}
template <bool LN>
__device__ __forceinline__ void stage_T(const bf16* P, int row0, int col0, LAS unsigned char* buf, int wave, int lane, const float* lng, const float* lnb) {
    float a[16], b[16];
    const bf16* src = P + (size_t)(row0 + 16 * wave) * NINP + col0 + 2 * lane;
#pragma unroll
    for (int s = 0; s < 16; ++s) { const unsigned v = *(const unsigned*)(src + (size_t)s * NINP); a[s] = bf_lo(v); b[s] = bf_hi(v); }
    if (LN) {
        const f32x2 g = *(const f32x2*)(lng + 2 * lane), bb = *(const f32x2*)(lnb + 2 * lane);
#pragma unroll
        for (int s = 0; s < 16; ++s) {
            const float mu = wave_sum(a[s] + b[s]) * (1.f / 128.f);
            const float da = a[s] - mu, db = b[s] - mu;
            const float rstd = rsqrtf(wave_sum(da * da + db * db) * (1.f / 128.f) + EPS);
            a[s] = da * rstd * g.x + bb.x; b[s] = db * rstd * g.y + bb.y;
        }
    }
    LAS u32x4* d0 = (LAS u32x4*)(buf + ((2 * lane) * LDT + 16 * wave) * 2);
    LAS u32x4* d1 = (LAS u32x4*)(buf + ((2 * lane + 1) * LDT + 16 * wave) * 2);
    d0[0] = (u32x4){pk2(a[0], a[1]), pk2(a[2], a[3]), pk2(a[4], a[5]), pk2(a[6], a[7])};
    d0[1] = (u32x4){pk2(a[8], a[9]), pk2(a[10], a[11]), pk2(a[12], a[13]), pk2(a[14], a[15])};
    d1[0] = (u32x4){pk2(b[0], b[1]), pk2(b[2], b[3]), pk2(b[4], b[5]), pk2(b[6], b[7])};
    d1[1] = (u32x4){pk2(b[8], b[9]), pk2(b[10], b[11]), pk2(b[12], b[13]), pk2(b[14], b[15])};
}
struct CumState { float cf[2][8], cb[2][8], tf[2], tb[2]; };
__device__ __forceinline__ void gate_dir(const float* wg, const float* bgp, const LAS unsigned char* rb, float (&la)[2][8]) {
    f32x2 wv[16];
#pragma unroll
    for (int t = 0; t < 16; ++t) wv[t] = *(const f32x2*)(wg + t * 256);
    const f32x2 bv = *(const f32x2*)bgp;
#pragma unroll
    for (int s = 0; s < 8; ++s) {
        const LAS f32x4* r = (const LAS f32x4*)(rb + s * 128);
        f32x2 pp = bv;
#pragma unroll
        for (int q = 0; q < 4; ++q) { const f32x4 rv = r[q];
#pragma unroll
            for (int e = 0; e < 4; ++e) pp = __builtin_elementwise_fma((f32x2){rv[e], rv[e]}, wv[4 * q + e], pp); }
        { const f32x2 l2 = logsig2_log2_16(pp); la[0][s] = l2.x; la[1][s] = l2.y; }
        if (s & 1) __builtin_amdgcn_sched_barrier(0);
    }
}
__device__ __forceinline__ void compute_cum(const Args& a, int l, int h, LAS unsigned char* lds, int wave, int lane, CumState& C) {
    const int p = lane & 31, seg = 2 * wave + (lane >> 5);
    const int co = l * 256 + h * 64 + 2 * p;
    const LAS unsigned char* rb = lds + RBUF_OFF + (8 * seg) * 128;
    gate_dir(a.in[7] + (size_t)l * 16 * 256 + h * 64 + 2 * p, a.in[8] + co, rb, C.cf);
    { float r0 = 0.f, r1 = 0.f;
#pragma unroll
      for (int s = 0; s < 8; ++s) { r0 += C.cf[0][s]; r1 += C.cf[1][s]; C.cf[0][s] = r0; C.cf[1][s] = r1; } }
    __builtin_amdgcn_sched_barrier(0);
    gate_dir(a.in[9] + (size_t)l * 16 * 256 + h * 64 + 2 * p, a.in[10] + co, rb + 64, C.cb);
    { float r0 = 0.f, r1 = 0.f;
#pragma unroll
      for (int s = 7; s >= 0; --s) { r0 += C.cb[0][s]; r1 += C.cb[1][s]; C.cb[0][s] = r0; C.cb[1][s] = r1; } }
    __builtin_amdgcn_sched_barrier(0);
    LAS float* tot = (LAS float*)(lds + TOT_OFF);
    *(LAS f32x2*)(tot + seg * 64 + 2 * p) = (f32x2){C.cf[0][7], C.cf[1][7]};
    *(LAS f32x2*)(tot + (16 + seg) * 64 + 2 * p) = (f32x2){C.cb[0][0], C.cb[1][0]};
    LBAR();
    float of0 = 0.f, of1 = 0.f, tf0 = 0.f, tf1 = 0.f, ob0 = 0.f, ob1 = 0.f, tb0 = 0.f, tb1 = 0.f;
#pragma unroll
    for (int sg = 0; sg < 16; ++sg) {
        const f32x2 x = *(const LAS f32x2*)(tot + sg * 64 + 2 * p), y = *(const LAS f32x2*)(tot + (16 + sg) * 64 + 2 * p);
        tf0 += x.x; tf1 += x.y; tb0 += y.x; tb1 += y.y;
        if (sg < seg) { of0 += x.x; of1 += x.y; }
        if (sg > seg) { ob0 += y.x; ob1 += y.y; }
    }
#pragma unroll
    for (int s = 0; s < 8; ++s) { C.cf[0][s] += of0; C.cf[1][s] += of1; C.cb[0][s] += ob0; C.cb[1][s] += ob1; }
    C.tf[0] = tf0; C.tf[1] = tf1; C.tb[0] = tb0; C.tb[1] = tb1;
    __builtin_amdgcn_sched_barrier(0);
}
__device__ __forceinline__ void mixer_a_item(const Args& a, int l, int item, LAS unsigned char* lds, int tid, int wave, int lane) {
    asm volatile("" : "+v"(tid)); lane = tid & 63;
    const int h = item & 3, row0 = (item >> 2) * 128;
    const bf16* P = (const bf16*)(a.ws + WS_P);
    const int p = lane & 31, seg = 2 * wave + (lane >> 5);
    LBAR();
    unsigned kraw[8];
    { const bf16* kp = P + (size_t)(row0 + 8 * seg) * NINP + 1280 + h * 64 + 2 * p;
#pragma unroll
    for (int s = 0; s < 8; ++s) kraw[s] = *(const unsigned*)(kp + (size_t)s * NINP); }
    stage_rbuf(P, row0, lds, tid);
    stage_T<false>(P, row0, 1536 + h * 128, lds + MB0, wave, lane, nullptr, nullptr);
    LBAR();
    CumState C; compute_cum(a, l, h, lds, wave, lane, C);
    { f32x4* cq = (f32x4*)(a.ws + WS_CUM) + (size_t)item * 4096 + tid;
      cq[0] = (f32x4){C.cf[0][0], C.cf[0][1], C.cf[0][2], C.cf[0][3]}; cq[512] = (f32x4){C.cf[0][4], C.cf[0][5], C.cf[0][6], C.cf[0][7]};
      cq[1024] = (f32x4){C.cf[1][0], C.cf[1][1], C.cf[1][2], C.cf[1][3]}; cq[1536] = (f32x4){C.cf[1][4], C.cf[1][5], C.cf[1][6], C.cf[1][7]};
      cq[2048] = (f32x4){C.cb[0][0], C.cb[0][1], C.cb[0][2], C.cb[0][3]}; cq[2560] = (f32x4){C.cb[0][4], C.cb[0][5], C.cb[0][6], C.cb[0][7]};
      cq[3072] = (f32x4){C.cb[1][0], C.cb[1][1], C.cb[1][2], C.cb[1][3]}; cq[3584] = (f32x4){C.cb[1][4], C.cb[1][5], C.cb[1][6], C.cb[1][7]}; }
    float k0[8], k1[8];
#pragma unroll
    for (int s = 0; s < 8; ++s) { k0[s] = bf_lo(kraw[s]); k1[s] = bf_hi(kraw[s]); }
    {
        const f32x2 tf2 = (f32x2){C.tf[0], C.tf[1]}, tb2 = (f32x2){C.tb[0], C.tb[1]};
        float ef0[8], ef1[8], eb0[8], eb1[8];
#pragma unroll
        for (int s = 0; s < 8; ++s) {
            const f32x2 k2 = (f32x2){k0[s], k1[s]};
            const f32x2 af = tf2 - (f32x2){C.cf[0][s], C.cf[1][s]}, ab = tb2 - (f32x2){C.cb[0][s], C.cb[1][s]};
            const f32x2 rf = k2 * (f32x2){__builtin_amdgcn_exp2f(af.x), __builtin_amdgcn_exp2f(af.y)}, rb2 = k2 * (f32x2){__builtin_amdgcn_exp2f(ab.x), __builtin_amdgcn_exp2f(ab.y)};
            ef0[s] = rf.x; ef1[s] = rf.y; eb0[s] = rb2.x; eb1[s] = rb2.y;
        }
        *(LAS u32x4*)(lds + MB2 + ((2 * p) * LDT + 8 * seg) * 2) = (u32x4){pk2(ef0[0], ef0[1]), pk2(ef0[2], ef0[3]), pk2(ef0[4], ef0[5]), pk2(ef0[6], ef0[7])};
        *(LAS u32x4*)(lds + MB2 + ((2 * p + 1) * LDT + 8 * seg) * 2) = (u32x4){pk2(ef1[0], ef1[1]), pk2(ef1[2], ef1[3]), pk2(ef1[4], ef1[5]), pk2(ef1[6], ef1[7])};
        *(LAS u32x4*)(lds + MB2 + ((64 + 2 * p) * LDT + 8 * seg) * 2) = (u32x4){pk2(eb0[0], eb0[1]), pk2(eb0[2], eb0[3]), pk2(eb0[4], eb0[5]), pk2(eb0[6], eb0[7])};
        *(LAS u32x4*)(lds + MB2 + ((64 + 2 * p + 1) * LDT + 8 * seg) * 2) = (u32x4){pk2(eb1[0], eb1[1]), pk2(eb1[2], eb1[3]), pk2(eb1[4], eb1[5]), pk2(eb1[6], eb1[7])};
    }
    if (seg == 0) { float* dec = (float*)(a.ws + WS_DEC) + (size_t)item * 128;
        *(f32x2*)(dec + 2 * p) = (f32x2){__builtin_amdgcn_exp2f(C.tf[0]), __builtin_amdgcn_exp2f(C.tf[1])}; *(f32x2*)(dec + 64 + 2 * p) = (f32x2){__builtin_amdgcn_exp2f(C.tb[0]), __builtin_amdgcn_exp2f(C.tb[1])}; }
    LBAR();
    const int dir = wave >> 2, r0 = 32 * (wave & 3), fr = lane & 15, fq = lane >> 4;
    float* DS = (float*)(a.ws + WS_DS) + (size_t)(item * 2 + dir) * 8192 + (r0 + 4 * fq) * 64 + fr;
#pragma unroll
    for (int n = 0; n < 4; ++n) {
        f32x4 acc[2] = {(f32x4){0.f, 0.f, 0.f, 0.f}, (f32x4){0.f, 0.f, 0.f, 0.f}};
        mma_rc<2, 4>((const LAS bf16*)(lds + MB0), LDT, r0, (const LAS bf16*)(lds + MB2) + dir * 64 * LDT, LDT, 16 * n, acc, lane);
#pragma unroll
        for (int t = 0; t < 2; ++t)
#pragma unroll
            for (int r = 0; r < 4; ++r) DS[(16 * t + r) * 64 + 16 * n] = acc[t][r];
    }
}
__device__ __forceinline__ void mixer_scan(const Args& a, int tid) {
    const float* DS = (const float*)(a.ws + WS_DS); const float* DEC = (const float*)(a.ws + WS_DEC); bf16* ST = (bf16*)(a.ws + WS_ST);
    for (int gid = blockIdx.x * NTHR + tid; gid < 16 * 8192; gid += gridDim.x * NTHR) {
        const int elem = gid & 8191, sq = gid >> 13, b = sq >> 3, h = (sq >> 1) & 3, dir = sq & 1;
        const long blk0 = (long)(((b * 64) * 4 + h) * 2 + dir) + (dir ? 63 * 8 : 0); const long bstep = dir ? -8 : 8;
        const float* dsp = DS + blk0 * 8192 + elem; const float* dcp = DEC + blk0 * 64 + (elem & 63); bf16* stp = ST + blk0 * 8192 + elem;
        float ds[64], dc[64];
#pragma unroll
        for (int s = 0; s < 64; ++s) { ds[s] = dsp[(long)s * bstep * 8192]; dc[s] = dcp[(long)s * bstep * 64]; }
        float S = 0.f;
#pragma unroll
        for (int s = 0; s < 64; ++s) { stp[(long)s * bstep * 8192] = (bf16)f2bf(S); S = S * dc[s] + ds[s]; }
    }
}
__device__ __forceinline__ void mixer_c_gla(const Args& a, int l, int item, LAS unsigned char* lds, int tid, int wave, int lane) {
    asm volatile("" : "+v"(tid)); lane = tid & 63;
    const int h = item & 3, row0 = (item >> 2) * 128;
    const bf16* P = (const bf16*)(a.ws + WS_P); bf16* MIX = (bf16*)(a.ws + WS_MIX); const bf16* ST = (const bf16*)(a.ws + WS_ST);
    __syncthreads();
    stage_rbuf(P, row0, lds, tid);
    stage_T<false>(P, row0, 1536 + h * 128, lds + MB0, wave, lane, nullptr, nullptr);
    __syncthreads();
    CumState C; compute_cum(a, l, h, lds, wave, lane, C);
    const int p = lane & 31, seg = 2 * wave + (lane >> 5);
    const bf16* prb = P + (size_t)(row0 + 8 * seg) * NINP + h * 64 + 2 * p;
    LAS unsigned char* qdb = lds + MB2 + (8 * seg * LDT + 2 * p) * 2; LAS unsigned char* kib = lds + MB3 + (8 * seg * LDK + 2 * p) * 2;
#pragma unroll
    for (int s = 0; s < 8; ++s) {
        const bf16* pr = prb + (size_t)s * NINP;
        const unsigned qv = *(const unsigned*)(pr + 1024), kv = *(const unsigned*)(pr + 1280);
        const float q0 = bf_lo(qv), q1 = bf_hi(qv), k0 = bf_lo(kv), k1 = bf_hi(kv);
        *(LAS unsigned*)(qdb + s * LDT * 2) = pk2(q0 * __expf(C.cf[0][s]), q1 * __expf(C.cf[1][s]));
        *(LAS unsigned*)(qdb + s * LDT * 2 + 128) = pk2(q0 * __expf(C.cb[0][s]), q1 * __expf(C.cb[1][s]));
        *(LAS unsigned*)(kib + s * LDK * 2) = pk2(k0 * __expf(-C.cf[0][s]), k1 * __expf(-C.cf[1][s]));
        *(LAS unsigned*)(kib + (128 + s) * LDK * 2) = pk2(k0 * __expf(-C.cb[0][s]), k1 * __expf(-C.cb[1][s]));
        if (s & 1) __builtin_amdgcn_sched_barrier(0);
    }
    __syncthreads();
    const int fr = lane & 15, fq = lane >> 4, w = wave;
#pragma unroll
    for (int t = 0; t < 8; ++t) {
        f32x4 sf[1] = {(f32x4){0.f, 0.f, 0.f, 0.f}}, sb[1] = {(f32x4){0.f, 0.f, 0.f, 0.f}};
        if (t <= w) mma_rc<1, 2>((const LAS bf16*)(lds + MB3), LDK, 16 * t, (const LAS bf16*)(lds + MB2), LDT, 16 * w, sf, lane);
        if (t >= w) mma_rc<1, 2>((const LAS bf16*)(lds + MB3) + 128 * LDK, LDK, 16 * t, (const LAS bf16*)(lds + MB2) + 64, LDT, 16 * w, sb, lane);
        const int i = 16 * w + fr, j0 = 16 * t + 4 * fq;
        float v[4];
#pragma unroll
        for (int r = 0; r < 4; ++r) v[r] = (j0 + r <= i) ? sf[0][r] : sb[0][r];
        *(LAS u32x2*)(lds + MB1 + (i * LDT + 4 * fq) * 2 + 32 * t) = (u32x2){pk2(v[0], v[1]), pk2(v[2], v[3])};
    }
    __syncthreads();
#pragma unroll
    for (int q = 0; q < 4; ++q) { const int c = tid + NTHR * q, dir = c >> 10, cc = c & 1023, e = cc >> 3, part = cc & 7;
        const u32x4 v = *(const u32x4*)(ST + (size_t)(item * 2 + dir) * 8192 + e * 64 + part * 8);
        *(LAS u32x4*)(lds + MB3 + (e * LDT + dir * 64 + part * 8) * 2) = v; }
    f32x4 acc[8];
#pragma unroll
    for (int t = 0; t < 8; ++t) acc[t] = (f32x4){0.f, 0.f, 0.f, 0.f};
    mma_rc<8, 4>((const LAS bf16*)(lds + MB0), LDT, 0, (const LAS bf16*)(lds + MB1), LDT, 16 * w, acc, lane);
    __syncthreads();
    mma_rc<8, 4>((const LAS bf16*)(lds + MB3), LDT, 0, (const LAS bf16*)(lds + MB2), LDT, 16 * w, acc, lane);
    float ss = 0.f;
#pragma unroll
    for (int t = 0; t < 8; ++t) ss += (acc[t][0] * acc[t][0] + acc[t][1] * acc[t][1]) + (acc[t][2] * acc[t][2] + acc[t][3] * acc[t][3]);
    ss += __shfl_xor(ss, 16); ss += __shfl_xor(ss, 32);
    const float rstd = rsqrtf(ss * (1.f / 128.f) + EPS);
    const int row = row0 + 16 * w + fr;
    const bf16* pg = P + (size_t)row * NINP + 2048 + h * 128 + 4 * fq; const float* gg = a.in[11] + (size_t)(l * 4 + h) * 128 + 4 * fq;
    bf16* mo = MIX + (size_t)row * D + 512 + h * 128 + 4 * fq;
#pragma unroll
    for (int t = 0; t < 8; ++t) { const u32x2 gv = *(const u32x2*)(pg + 16 * t); const f32x4 g4 = *(const f32x4*)(gg + 16 * t);
        const float o0 = acc[t][0] * rstd * g4[0] * silu_f(bf_lo(gv.x)), o1 = acc[t][1] * rstd * g4[1] * silu_f(bf_hi(gv.x));
        const float o2 = acc[t][2] * rstd * g4[2] * silu_f(bf_lo(gv.y)), o3 = acc[t][3] * rstd * g4[3] * silu_f(bf_hi(gv.y));
        *(u32x2*)(mo + 16 * t) = (u32x2){pk2(o0, o1), pk2(o2, o3)}; }
}
__device__ __forceinline__ void mixer_c_gmlp(const Args& a, int l, int item, LAS unsigned char* lds, int tid, int wave, int lane) {
    asm volatile("" : "+v"(tid)); lane = tid & 63;
    const int h = item & 3, row0 = (item >> 2) * 128;
    const bf16* P = (const bf16*)(a.ws + WS_P); bf16* MIX = (bf16*)(a.ws + WS_MIX);
    __syncthreads();
    { const float* Ws = a.in[3] + (size_t)(l * 4 + h) * 16384; const int r = tid >> 2, cp = (tid & 3) * 32;
#pragma unroll
      for (int q = 0; q < 4; ++q) { const f32x4 x0 = *(const f32x4*)(Ws + r * 128 + cp + 8 * q), x1 = *(const f32x4*)(Ws + r * 128 + cp + 8 * q + 4);
          *(LAS u32x4*)(lds + MB1 + (r * LDT + cp + 8 * q) * 2) = (u32x4){pk2(x0[0], x0[1]), pk2(x0[2], x0[3]), pk2(x1[0], x1[1]), pk2(x1[2], x1[3])}; } }
    stage_T<true>(P, row0, 512 + h * 128, lds + MB0, wave, lane, a.in[5] + (size_t)(l * 4 + h) * 128, a.in[6] + (size_t)(l * 4 + h) * 128);
    __syncthreads();
    const int fr = lane & 15, fq = lane >> 4, w = wave;
    f32x4 acc[8];
#pragma unroll
    for (int t = 0; t < 8; ++t) acc[t] = (f32x4){0.f, 0.f, 0.f, 0.f};
    mma_rc<8, 4>((const LAS bf16*)(lds + MB0), LDT, 0, (const LAS bf16*)(lds + MB1), LDT, 16 * w, acc, lane);
    const float bsv = a.in[4][(size_t)(l * 4 + h) * 128 + 16 * w + fr];
    const int row = row0 + 16 * w + fr;
    const bf16* up = P + (size_t)row * NINP + h * 128 + 4 * fq; bf16* mo = MIX + (size_t)row * D + h * 128 + 4 * fq;
#pragma unroll
    for (int t = 0; t < 8; ++t) { const u32x2 uv = *(const u32x2*)(up + 16 * t);
        const float o0 = bf_lo(uv.x) * (acc[t][0] + bsv), o1 = bf_hi(uv.x) * (acc[t][1] + bsv), o2 = bf_lo(uv.y) * (acc[t][2] + bsv), o3 = bf_hi(uv.y) * (acc[t][3] + bsv);
        *(u32x2*)(mo + 16 * t) = (u32x2){pk2(o0, o1), pk2(o2, o3)}; }
}
__device__ __forceinline__ void mixer_gla_item(const Args& a, int l, int item, LAS unsigned char* lds, int tid, int wave, int lane, const XcdBarrier& xb, const bool first) {
    asm volatile("" : "+v"(tid)); lane = tid & 63;
    const int h = item & 3, row0 = (item >> 2) * 128;
    const bf16* P = (const bf16*)(a.ws + WS_P); bf16* MIX = (bf16*)(a.ws + WS_MIX); const bf16* ST = (const bf16*)(a.ws + WS_ST);
    const int p = lane & 31, seg = 2 * wave + (lane >> 5), fr = lane & 15, fq = lane >> 4, w = wave;
    const int orow = row0 + 16 * w + fr;
    LBAR();
    unsigned vraw[16];
    { const bf16* src = P + (size_t)(row0 + 16 * wave) * NINP + 1536 + h * 128 + 2 * lane;
#pragma unroll
      for (int s = 0; s < 16; ++s) vraw[s] = *(const unsigned*)(src + (size_t)s * NINP); }
    unsigned qv[8], kv[8];
    { const bf16* prb = P + (size_t)(row0 + 8 * seg) * NINP + h * 64 + 2 * p;
#pragma unroll
      for (int s = 0; s < 8; ++s) { qv[s] = *(const unsigned*)(prb + (size_t)s * NINP + 1024); kv[s] = *(const unsigned*)(prb + (size_t)s * NINP + 1280); } }
    f32x4 cq[8];
    { const f32x4* cp = (const f32x4*)(a.ws + WS_CUM) + (size_t)item * 4096 + tid;
#pragma unroll
      for (int j = 0; j < 8; ++j) cq[j] = cp[512 * j]; }
    u32x2 pgv[8];
    { const bf16* pg = P + (size_t)orow * NINP + 2048 + h * 128 + 4 * fq;
#pragma unroll
      for (int t = 0; t < 8; ++t) pgv[t] = *(const u32x2*)(pg + 16 * t); }
    { LAS u32x4* d0 = (LAS u32x4*)(lds + MB0 + ((2 * lane) * LDT + 16 * wave) * 2); LAS u32x4* d1 = (LAS u32x4*)(lds + MB0 + ((2 * lane + 1) * LDT + 16 * wave) * 2);
#define LO2(x, y) (((x) & 0xffffu) | ((y) << 16))
#define HI2(x, y) (((x) >> 16) | ((y) & 0xffff0000u))
      d0[0] = (u32x4){LO2(vraw[0], vraw[1]), LO2(vraw[2], vraw[3]), LO2(vraw[4], vraw[5]), LO2(vraw[6], vraw[7])};
      d0[1] = (u32x4){LO2(vraw[8], vraw[9]), LO2(vraw[10], vraw[11]), LO2(vraw[12], vraw[13]), LO2(vraw[14], vraw[15])};
      d1[0] = (u32x4){HI2(vraw[0], vraw[1]), HI2(vraw[2], vraw[3]), HI2(vraw[4], vraw[5]), HI2(vraw[6], vraw[7])};
      d1[1] = (u32x4){HI2(vraw[8], vraw[9]), HI2(vraw[10], vraw[11]), HI2(vraw[12], vraw[13]), HI2(vraw[14], vraw[15])}; }
    CumState C;
#pragma unroll
    for (int q = 0; q < 4; ++q) { C.cf[0][q] = cq[0][q]; C.cf[0][4 + q] = cq[1][q]; C.cf[1][q] = cq[2][q]; C.cf[1][4 + q] = cq[3][q]; C.cb[0][q] = cq[4][q]; C.cb[0][4 + q] = cq[5][q]; C.cb[1][q] = cq[6][q]; C.cb[1][4 + q] = cq[7][q]; }
    { LAS unsigned char* qdb = lds + MB2 + (8 * seg * LDT + 2 * p) * 2; LAS unsigned char* kib = lds + MB3 + (8 * seg * LDK + 2 * p) * 2;
#pragma unroll
      for (int s = 0; s < 8; ++s) {
        const f32x2 q2 = (f32x2){bf_lo(qv[s]), bf_hi(qv[s])}, k2 = (f32x2){bf_lo(kv[s]), bf_hi(kv[s])};
        const f32x2 ef = (f32x2){__builtin_amdgcn_exp2f(C.cf[0][s]), __builtin_amdgcn_exp2f(C.cf[1][s])}, eb = (f32x2){__builtin_amdgcn_exp2f(C.cb[0][s]), __builtin_amdgcn_exp2f(C.cb[1][s])};
        const f32x2 nf = (f32x2){__builtin_amdgcn_exp2f(-C.cf[0][s]), __builtin_amdgcn_exp2f(-C.cf[1][s])}, nb = (f32x2){__builtin_amdgcn_exp2f(-C.cb[0][s]), __builtin_amdgcn_exp2f(-C.cb[1][s])};
        const f32x2 qf = q2 * ef, qb = q2 * eb, kf = k2 * nf, kb = k2 * nb;
        *(LAS unsigned*)(qdb + s * LDT * 2) = pk2(qf.x, qf.y);
        *(LAS unsigned*)(qdb + s * LDT * 2 + 128) = pk2(qb.x, qb.y);
        *(LAS unsigned*)(kib + s * LDK * 2) = pk2(kf.x, kf.y);
        *(LAS unsigned*)(kib + (128 + s) * LDK * 2) = pk2(kb.x, kb.y);
        if (s & 1) __builtin_amdgcn_sched_barrier(0);
      } }
    LBAR();
    if (first) xcd_wait(xb, tid);
    u32x4 stv[4];
#pragma unroll
    for (int q = 0; q < 4; ++q) { const int c = tid + NTHR * q, dir = c >> 10, cc = c & 1023; stv[q] = *(const u32x4*)(ST + (size_t)(item * 2 + dir) * 8192 + (cc >> 3) * 64 + (cc & 7) * 8); }
#pragma unroll
    for (int t = 0; t < 8; ++t) {
        f32x4 sf[1] = {(f32x4){0.f, 0.f, 0.f, 0.f}}, sb[1] = {(f32x4){0.f, 0.f, 0.f, 0.f}};
        if (t <= w) mma_rc<1, 2>((const LAS bf16*)(lds + MB3), LDK, 16 * t, (const LAS bf16*)(lds + MB2), LDT, 16 * w, sf, lane);
        if (t >= w) mma_rc<1, 2>((const LAS bf16*)(lds + MB3) + 128 * LDK, LDK, 16 * t, (const LAS bf16*)(lds + MB2) + 64, LDT, 16 * w, sb, lane);
        const int i = 16 * w + fr, j0 = 16 * t + 4 * fq;
        float v[4];
#pragma unroll
        for (int r = 0; r < 4; ++r) v[r] = (j0 + r <= i) ? sf[0][r] : sb[0][r];
        *(LAS u32x2*)(lds + MB1 + (i * LDT + 4 * fq) * 2 + 32 * t) = (u32x2){pk2(v[0], v[1]), pk2(v[2], v[3])};
    }
    LBAR();
#pragma unroll
    for (int q = 0; q < 4; ++q) { const int c = tid + NTHR * q, dir = c >> 10, cc = c & 1023; *(LAS u32x4*)(lds + MB3 + ((cc >> 3) * LDT + dir * 64 + (cc & 7) * 8) * 2) = stv[q]; }
    f32x4 acc[8];
#pragma unroll
    for (int t = 0; t < 8; ++t) acc[t] = (f32x4){0.f, 0.f, 0.f, 0.f};
    mma_rc<8, 4>((const LAS bf16*)(lds + MB0), LDT, 0, (const LAS bf16*)(lds + MB1), LDT, 16 * w, acc, lane);
    LBAR();
    mma_rc<8, 4>((const LAS bf16*)(lds + MB3), LDT, 0, (const LAS bf16*)(lds + MB2), LDT, 16 * w, acc, lane);
    {   float ss = 0.f;
#pragma unroll
        for (int t = 0; t < 8; ++t) ss += (acc[t][0] * acc[t][0] + acc[t][1] * acc[t][1]) + (acc[t][2] * acc[t][2] + acc[t][3] * acc[t][3]);
        ss += __shfl_xor(ss, 16); ss += __shfl_xor(ss, 32);
        const float rstd = rsqrtf(ss * (1.f / 128.f) + EPS);
        const float* gg = a.in[11] + (size_t)(l * 4 + h) * 128 + 4 * fq; bf16* mo = MIX + (size_t)orow * D + 512 + h * 128 + 4 * fq;
        f32x4 g4a[8];
#pragma unroll
        for (int t = 0; t < 8; ++t) g4a[t] = *(const f32x4*)(gg + 16 * t);
#pragma unroll
        for (int t = 0; t < 8; ++t) { const f32x4 g4 = g4a[t];
            const f32x4 ov4 = (acc[t] * rstd) * g4 * silu4((f32x4){bf_lo(pgv[t].x), bf_hi(pgv[t].x), bf_lo(pgv[t].y), bf_hi(pgv[t].y)});
            const float o0 = ov4[0], o1 = ov4[1], o2 = ov4[2], o3 = ov4[3];
            *(u32x2*)(mo + 16 * t) = (u32x2){pk2(o0, o1), pk2(o2, o3)}; } }
}
__device__ __forceinline__ void mixer_gmlp_item(const Args& a, int l, int item, LAS unsigned char* lds, int tid, int wave, int lane) {
    asm volatile("" : "+v"(tid)); lane = tid & 63;
    const int h = item & 3, row0 = (item >> 2) * 128;
    const bf16* P = (const bf16*)(a.ws + WS_P); bf16* MIX = (bf16*)(a.ws + WS_MIX);
    const int fr = lane & 15, fq = lane >> 4, w = wave;
    const int orow = row0 + 16 * w + fr;
    LBAR();
    f32x4 wsv[8];
    { const float* Ws = a.in[3] + (size_t)(l * 4 + h) * 16384 + (tid >> 2) * 128 + (tid & 3) * 32;
#pragma unroll
      for (int q = 0; q < 8; ++q) wsv[q] = *(const f32x4*)(Ws + 4 * q); }
    unsigned araw[16];
    { const bf16* src = P + (size_t)(row0 + 16 * wave) * NINP + 512 + h * 128 + 2 * lane;
#pragma unroll
      for (int s = 0; s < 16; ++s) araw[s] = *(const unsigned*)(src + (size_t)s * NINP); }
    u32x2 uv[8];
    { const bf16* up = P + (size_t)orow * NINP + h * 128 + 4 * fq;
#pragma unroll
      for (int t = 0; t < 8; ++t) uv[t] = *(const u32x2*)(up + 16 * t); }
    { const int r = tid >> 2, cp = (tid & 3) * 32;
#pragma unroll
      for (int q = 0; q < 4; ++q) *(LAS u32x4*)(lds + MB1 + (r * LDT + cp + 8 * q) * 2) = (u32x4){pk2(wsv[2 * q][0], wsv[2 * q][1]), pk2(wsv[2 * q][2], wsv[2 * q][3]), pk2(wsv[2 * q + 1][0], wsv[2 * q + 1][1]), pk2(wsv[2 * q + 1][2], wsv[2 * q + 1][3])}; }
    { float av[16], bv[16];
      const f32x2 g = *(const f32x2*)(a.in[5] + (size_t)(l * 4 + h) * 128 + 2 * lane), bb = *(const f32x2*)(a.in[6] + (size_t)(l * 4 + h) * 128 + 2 * lane);
#pragma unroll
      for (int s = 0; s < 16; ++s) {
          const f32x2 xv = (f32x2){bf_lo(araw[s]), bf_hi(araw[s])};
          const float mu = wave_sum_dpp(xv.x + xv.y) * (1.f / 128.f);
          const f32x2 dv = xv - mu, sq = dv * dv;
          const float rstd = rsqrtf(wave_sum_dpp(sq.x + sq.y) * (1.f / 128.f) + EPS);
          const f32x2 ov2 = __builtin_elementwise_fma(dv * rstd, g, bb);
          av[s] = ov2.x; bv[s] = ov2.y;
      }
      LAS u32x4* d0 = (LAS u32x4*)(lds + MB0 + ((2 * lane) * LDT + 16 * wave) * 2); LAS u32x4* d1 = (LAS u32x4*)(lds + MB0 + ((2 * lane + 1) * LDT + 16 * wave) * 2);
      d0[0] = (u32x4){pk2(av[0], av[1]), pk2(av[2], av[3]), pk2(av[4], av[5]), pk2(av[6], av[7])};
      d0[1] = (u32x4){pk2(av[8], av[9]), pk2(av[10], av[11]), pk2(av[12], av[13]), pk2(av[14], av[15])};
      d1[0] = (u32x4){pk2(bv[0], bv[1]), pk2(bv[2], bv[3]), pk2(bv[4], bv[5]), pk2(bv[6], bv[7])};
      d1[1] = (u32x4){pk2(bv[8], bv[9]), pk2(bv[10], bv[11]), pk2(bv[12], bv[13]), pk2(bv[14], bv[15])}; }
    LBAR();
    f32x4 acc[8];
#pragma unroll
    for (int t = 0; t < 8; ++t) acc[t] = (f32x4){0.f, 0.f, 0.f, 0.f};
    mma_rc<8, 4>((const LAS bf16*)(lds + MB0), LDT, 0, (const LAS bf16*)(lds + MB1), LDT, 16 * w, acc, lane);
    {   const float bsv = a.in[4][(size_t)(l * 4 + h) * 128 + 16 * w + fr];
        bf16* mo = MIX + (size_t)orow * D + h * 128 + 4 * fq;
#pragma unroll
        for (int t = 0; t < 8; ++t) {
            const f32x4 ov4 = (f32x4){bf_lo(uv[t].x), bf_hi(uv[t].x), bf_lo(uv[t].y), bf_hi(uv[t].y)} * (acc[t] + bsv); const float o0 = ov4[0], o1 = ov4[1], o2 = ov4[2], o3 = ov4[3];
            *(u32x2*)(mo + 16 * t) = (u32x2){pk2(o0, o1), pk2(o2, o3)}; } }
}
__device__ __forceinline__ void unpack8(const u32x4 v, float (&f)[8]) { f[0] = bf_lo(v.x); f[1] = bf_hi(v.x); f[2] = bf_lo(v.y); f[3] = bf_hi(v.y); f[4] = bf_lo(v.z); f[5] = bf_hi(v.z); f[6] = bf_lo(v.w); f[7] = bf_hi(v.w); }
__device__ __forceinline__ void conv_act(const Args& a, int l, int tid) {
    const bf16* Y = (const bf16*)(a.ws + WS_R1); bf16* ACT = (bf16*)(a.ws + WS_R2);
    const float* cw = a.in[15] + (size_t)l * 3 * NUP; const float* cb = a.in[16] + (size_t)l * NUP;
    constexpr int NCG = FF / 8, NT = (M / 8) * NCG;
    for (int t = blockIdx.x * NTHR + tid; t < NT; t += gridDim.x * NTHR) {
        const int cgp = t % NCG, rg = t / NCG, j0 = cgp * 8, m0 = rg * 8, pos = m0 & (SEQ - 1);
        float wg[3][8], wv[3][8], bg[8], bv[8];
#pragma unroll
        for (int k = 0; k < 3; ++k)
#pragma unroll
            for (int q = 0; q < 2; ++q) { const f32x4 x = *(const f32x4*)(cw + k * NUP + j0 + 4 * q), y = *(const f32x4*)(cw + k * NUP + FF + j0 + 4 * q);
#pragma unroll
                for (int e = 0; e < 4; ++e) { wg[k][4 * q + e] = x[e]; wv[k][4 * q + e] = y[e]; } }
#pragma unroll
        for (int q = 0; q < 2; ++q) { const f32x4 x = *(const f32x4*)(cb + j0 + 4 * q), y = *(const f32x4*)(cb + FF + j0 + 4 * q);
#pragma unroll
            for (int e = 0; e < 4; ++e) { bg[4 * q + e] = x[e]; bv[4 * q + e] = y[e]; } }
        float pg[8], pv[8], cgv[8], cv[8], ng[8], nv[8];
        const bf16* yr = Y + (size_t)m0 * NUP + j0;
        if (pos > 0) { unpack8(*(const u32x4*)(yr - NUP), pg); unpack8(*(const u32x4*)(yr - NUP + FF), pv); }
        else {
#pragma unroll
            for (int e = 0; e < 8; ++e) { pg[e] = 0.f; pv[e] = 0.f; } }
        unpack8(*(const u32x4*)(yr), cgv); unpack8(*(const u32x4*)(yr + FF), cv);
#pragma unroll
        for (int r = 0; r < 8; ++r) {
            if (r < 7 || pos + 8 < SEQ) { unpack8(*(const u32x4*)(yr + (size_t)(r + 1) * NUP), ng); unpack8(*(const u32x4*)(yr + (size_t)(r + 1) * NUP + FF), nv); }
            else {
#pragma unroll
                for (int e = 0; e < 8; ++e) { ng[e] = 0.f; nv[e] = 0.f; } }
            float o[8];
#pragma unroll
            for (int e = 0; e < 8; ++e) { const float zg = bg[e] + pg[e] * wg[0][e] + cgv[e] * wg[1][e] + ng[e] * wg[2][e];
                const float zv = bv[e] + pv[e] * wv[0][e] + cv[e] * wv[1][e] + nv[e] * wv[2][e]; o[e] = silu_f(zg) * zv; }
            *(u32x4*)(ACT + (size_t)(m0 + r) * FF + j0) = (u32x4){pk2(o[0], o[1]), pk2(o[2], o[3]), pk2(o[4], o[5]), pk2(o[6], o[7])};
#pragma unroll
            for (int e = 0; e < 8; ++e) { pg[e] = cgv[e]; pv[e] = cv[e]; cgv[e] = ng[e]; cv[e] = nv[e]; }
        }
    }
}

__device__ __forceinline__ void conv_fix(const Args& a, int l, int tid) {
    const bf16* YB = (const bf16*)(a.ws + WS_R1); bf16* ACT = (bf16*)(a.ws + WS_R2);
    const float* cw = a.in[15] + (size_t)l * 3 * NUP; const float* cb = a.in[16] + (size_t)l * NUP;
    constexpr int NCG = FF / 8, NT = (M / 64) * 2 * NCG;
    for (int t = blockIdx.x * NTHR + tid; t < NT; t += gridDim.x * NTHR) {
        const int cgp = t % NCG, bw = t / NCG, which = bw & 1, blk = bw >> 1, j0 = cgp * 8;
        const int colg = 256 * (j0 >> 7) + (j0 & 127), row = blk * 64 + (which ? 63 : 0), pos = row & (SEQ - 1);
        float wg[3][8], wv[3][8], bg[8], bv[8];
#pragma unroll
        for (int k = 0; k < 3; ++k)
#pragma unroll
            for (int q = 0; q < 2; ++q) { const f32x4 x = *(const f32x4*)(cw + k * NUP + j0 + 4 * q), y = *(const f32x4*)(cw + k * NUP + FF + j0 + 4 * q);
#pragma unroll
                for (int e = 0; e < 4; ++e) { wg[k][4 * q + e] = x[e]; wv[k][4 * q + e] = y[e]; } }
#pragma unroll
        for (int q = 0; q < 2; ++q) { const f32x4 x = *(const f32x4*)(cb + j0 + 4 * q), y = *(const f32x4*)(cb + FF + j0 + 4 * q);
#pragma unroll
            for (int e = 0; e < 4; ++e) { bg[4 * q + e] = x[e]; bv[4 * q + e] = y[e]; } }
        const bf16* yb = YB + (size_t)(blk * 4) * NUP + colg;
        const bf16* pp = which ? yb + 2 * (size_t)NUP : yb - (size_t)NUP;
        const bf16* cp = which ? yb + 3 * (size_t)NUP : yb;
        const bf16* np = which ? yb + 4 * (size_t)NUP : yb + (size_t)NUP;
        const bool hasp = which || pos > 0, hasn = !which || pos < SEQ - 1;
        float pg[8], pv[8], cgv[8], cv[8], ng[8], nv[8];
        if (hasp) { unpack8(*(const u32x4*)pp, pg); unpack8(*(const u32x4*)(pp + 128), pv); }
        else {
#pragma unroll
            for (int e = 0; e < 8; ++e) { pg[e] = 0.f; pv[e] = 0.f; } }
        unpack8(*(const u32x4*)cp, cgv); unpack8(*(const u32x4*)(cp + 128), cv);
        if (hasn) { unpack8(*(const u32x4*)np, ng); unpack8(*(const u32x4*)(np + 128), nv); }
        else {
#pragma unroll
            for (int e = 0; e < 8; ++e) { ng[e] = 0.f; nv[e] = 0.f; } }
        float o[8];
#pragma unroll
        for (int e = 0; e < 8; ++e) { const float zg = bg[e] + pg[e] * wg[0][e] + cgv[e] * wg[1][e] + ng[e] * wg[2][e];
            const float zv = bv[e] + pv[e] * wv[0][e] + cv[e] * wv[1][e] + nv[e] * wv[2][e]; o[e] = silu_f(zg) * zv; }
        *(u32x4*)(ACT + (size_t)row * FF + j0) = (u32x4){pk2(o[0], o[1]), pk2(o[2], o[3]), pk2(o[4], o[5]), pk2(o[6], o[7])};
    }
}

#ifndef DUP_MASK
#define DUP_MASK 0
#endif
typedef const __attribute__((address_space(4))) Args* KArgsPtr;
__device__ __forceinline__ const Args& kargs() { KArgsPtr p = (KArgsPtr)__builtin_amdgcn_kernarg_segment_ptr(); asm volatile("" : "+s"(p)); return *(const Args*)p; }
__device__ __forceinline__ int lane_id() { return (int)__builtin_amdgcn_mbcnt_hi(~0u, __builtin_amdgcn_mbcnt_lo(~0u, 0u)); }
constexpr int NPH_L = 8;
template <int L, int S>
__device__ __forceinline__ void phase_body(LAS unsigned char* lds, const int wave_s, const XcdBarrier& xb) {
    const Args& a = kargs();
    int lane = lane_id(); asm volatile("" : "+v"(lane));
    const int wave = wave_s, tid = wave * 64 + lane, gw = blockIdx.x * 8 + wave;
    const int G = gridDim.x, NGW = G * 8;
    bf16* XB = (bf16*)(a.ws + WS_XB); bf16* Pb = (bf16*)(a.ws + WS_P); bf16* MIX = (bf16*)(a.ws + WS_MIX); bf16* Yb = (bf16*)(a.ws + WS_R1); bf16* ACT = (bf16*)(a.ws + WS_R2);
    float* SSM = (float*)(a.ws + WS_SSM); float* SSF = (float*)(a.ws + WS_SSF);
    const bf16* Win_t = (const bf16*)(a.ws + WS_WIN); const bf16* Wout_t = (const bf16*)(a.ws + WS_WOUT); const bf16* Wup_t = (const bf16*)(a.ws + WS_WUP); const bf16* Wdn_t = (const bf16*)(a.ws + WS_WDOWN);
    if constexpr (L < 0) {
        convert_weights(a, 0, 5, lds, gw, NGW, wave, lane);
        prologue_rows(a.in[0], a.in[1], XB, SSM, gw, NGW, lane);
    } else if constexpr (S == 0) {
        pg8::Gemm g{XB, Win_t, M, NINP, D}; PrefetchOrder So; So.init(M, NINP, G, (int)blockIdx.x); So.ssp = SSM; So.cw = nullptr; So.cb = nullptr; So.xl = lds + XL_OFF; So.tid = tid; So.cnt = 0; EpiIn E{Pb, lds + XL_OFF, 0};
        pg8::gemm_phase<EpiIn, PrefetchOrder, PG8_ALIGN, PG8_SP2>(lds, g, So, E, tid);
    } else if constexpr (S == 1) {
        for (int item = blockIdx.x; item < 512; item += G) mixer_a_item(a, L, item, lds, tid, wave, lane);
        xcd_arrive(xb, tid);
        for (int item = blockIdx.x; item < 512; item += G) mixer_gmlp_item(a, L, item, lds, tid, wave, lane);
        xcd_wait(xb, tid);
    } else if constexpr (S == 2) {
        mixer_scan(a, tid);
        xcd_arrive(xb, tid);
    } else if constexpr (S == 3) {
        for (int item = blockIdx.x; item < 512; item += G) mixer_gla_item(a, L, item, lds, tid, wave, lane, xb, item == (int)blockIdx.x);
        xcd_arrive(xb, tid);
        convert_weights(a, L, 2, lds, gw, NGW, wave, lane);
        xcd_wait(xb, tid);
    } else if constexpr (S == 4) {
        pg8::Gemm g{MIX, Wout_t, M, D, D}; pg8::StaticOrder So; So.init(M, D, G, (int)blockIdx.x); EpiRes16<false> E{XB, nullptr, SSF, nullptr, nullptr};
        pg8::gemm_phase<EpiRes16<false>, pg8::StaticOrder, false, PG8_SP2>(lds, g, So, E, tid);
    } else if constexpr (S == 5) {
        pg8::Gemm g{XB, Wup_t, M, NUP, D}; PrefetchOrder So; So.init(M, NUP, G, (int)blockIdx.x); So.ssp = SSF; So.cw = a.in[15] + (size_t)L * 3 * NUP; So.cb = a.in[16] + (size_t)L * NUP; So.xl = lds + XL_OFF; So.tid = tid; So.cnt = 0; EpiUpConv E{ACT, Yb, lds + XL_OFF, 0};
        pg8::gemm_phase<EpiUpConv, PrefetchOrder, PG8_ALIGN, PG8_SP2>(lds, g, So, E, tid);
        { constexpr int NU = (M / 256) * (NUP / 256); const int nfull = NU % G;
          if (L + 1 < DEPTH && (int)blockIdx.x >= nfull) convert_weights(a, L + 1, 1, lds, ((int)blockIdx.x - nfull) * 8 + wave, (G - nfull) * 8, wave, lane); }
        xcd_barrier(xb, tid);
    } else if constexpr (S == 6) {
        conv_fix(a, L, tid);
        if (L + 1 < DEPTH) { xcd_arrive(xb, tid); convert_weights(a, L + 1, 4, lds, gw, NGW, wave, lane); xcd_wait(xb, tid); }
        else xcd_barrier(xb, tid);
    } else if constexpr (S == 7) {
        pg8::Gemm g{ACT, Wdn_t, M, D, FF}; pg8::StaticOrder So; So.init(M, D, G, (int)blockIdx.x); EpiRes16<(L + 1 == DEPTH)> E{XB, a.out, SSM, a.in[18], (unsigned*)a.ws + CW_PCNT};
        pg8::gemm_phase<EpiRes16<(L + 1 == DEPTH)>, pg8::StaticOrder, false, PG8_SP2>(lds, g, So, E, tid);
    } else {
        final_rows(a.out, a.in[18], SSM, gw, NGW, lane);
    }
}
#define SEAM() do { const int t_ = wave_s * 64 + lane_id(); xcd_barrier(xb, t_); } while (0)
#define RUN(L, S) { constexpr int k_ = 1 + NPH_L * (L) + (S); if (ph_lo <= k_ && k_ < ph_hi) { phase_body<L, S>(lds, wave_s, xb); \
    if constexpr ((S) == 0 || (S) == 4 || (S) == 7) { if (k_ + 1 < ph_hi) SEAM(); } } }
#define RUN_LAYER(L) RUN(L, 0) RUN(L, 1) RUN(L, 2) RUN(L, 3) RUN(L, 4) RUN(L, 5) RUN(L, 6) RUN(L, 7)
__global__ void __launch_bounds__(NTHR, 2) mk_fwd(Args a) {
    extern __shared__ __attribute__((aligned(16))) unsigned char lds_raw[];
    LAS unsigned char* lds = (LAS unsigned char*)lds_raw;
    cg::grid_group grid = cg::this_grid();
    const int wave_s = __builtin_amdgcn_readfirstlane((int)(threadIdx.x >> 6));
    volatile LAS unsigned* MISC = (volatile LAS unsigned*)(lds + MISC_OFF);
    if (threadIdx.x < 4) MISC[threadIdx.x] = 0u;
    __syncthreads();
    const int ph_lo = kargs().ph_lo, ph_hi = kargs().ph_hi;
    XcdBarrier xb = xcd_barrier_post((unsigned*)kargs().ws + CW_BAR, MISC, (int)threadIdx.x);
    if (ph_lo <= 0 && 0 < ph_hi) {
        phase_body<-1, 0>(lds, wave_s, xb);
        if (ph_lo < -1) grid.sync();
        if (1 < ph_hi) SEAM();
    }
    RUN_LAYER(0)
    RUN_LAYER(1)
    RUN_LAYER(2)
    RUN_LAYER(3)
}

extern "C" void kernel_launch(void* const* d_in, const int* in_sizes, int n_in, void* d_out, int out_size, void* d_ws, size_t ws_size, hipStream_t stream) {
    static int grid = 0;
    if (grid == 0) {
        if (n_in != 19 || out_size != M * D || ws_size < WS_END) { fprintf(stderr, "kernel_launch: unexpected shapes / workspace (%d inputs, out %d, ws %zu)\n", n_in, out_size, ws_size); grid = -1; return; }
        int dev = 0, cus = 0, per_cu = 0;
        hipGetDevice(&dev); hipDeviceGetAttribute(&cus, hipDeviceAttributeMultiprocessorCount, dev);
        hipFuncSetAttribute((const void*)mk_fwd, hipFuncAttributeMaxDynamicSharedMemorySize, LDS_BYTES);
        hipOccupancyMaxActiveBlocksPerMultiprocessor(&per_cu, (const void*)mk_fwd, NTHR, LDS_BYTES);
        if (per_cu < 1) per_cu = 1;
        grid = cus * per_cu;
        if (grid != 256) { fprintf(stderr, "kernel_launch: built for a 256-workgroup grid (one per CU), got %d\n", grid); grid = -1; return; }
        (void)hipGetLastError();
    }
    if (grid < 0) return;
    if (hipMemsetAsync(d_ws, 0, CTL_ZERO_BYTES, stream) != hipSuccess) return;
    Args a{};
    for (int i = 0; i < 19; ++i) a.in[i] = (const float*)d_in[i];
    a.out = (float*)d_out; a.ws = (unsigned char*)d_ws;
#if MK_SINGLE
    a.ph_lo = 0; a.ph_hi = NPHASE;
    void* args[] = {&a};
    hipError_t e = hipLaunchCooperativeKernel((const void*)mk_fwd, dim3(grid), dim3(NTHR), args, LDS_BYTES, stream);
    if (e != hipSuccess) fprintf(stderr, "cooperative launch failed: %s (grid %d)\n", hipGetErrorString(e), grid);
#else
    for (int ph = 0; ph < NPHASE; ++ph) { a.ph_lo = ph; a.ph_hi = ph + 1; hipLaunchKernelGGL(mk_fwd, dim3(grid), dim3(NTHR), LDS_BYTES, stream, a); }
#endif
}
```

```cpp
#include <hip/hip_runtime.h>
#include <hip/hip_cooperative_groups.h>
#include <cstdio>
#include <cstdint>
namespace pg8 {
#define PG8_LAS __attribute__((address_space(3)))
typedef unsigned short bf16_t;
typedef short bf16x8 __attribute__((ext_vector_type(8)));
typedef float f32x4 __attribute__((ext_vector_type(4)));
typedef unsigned u32x4 __attribute__((ext_vector_type(4)));
constexpr int BM = 256, BK = 64, HALF = 128, HTB = HALF * BK * 2  , STAGE_BYTES = 8 * HTB, NXCD = 8, WGM = 8;

__host__ __device__ __forceinline__ int lds_byte(int r, int c) { const int st = (r >> 4) * 2 + (c >> 5), rr = r & 15, cc = c & 31, ob = rr * 64 + cc * 2; return st * 1024 + (ob ^ (((ob >> 9) & 1) << 5)); }
__host__ __device__ __forceinline__ void stage_rc(int b, int& R, int& C) { const int st = b / 1024, sb = b % 1024, swz = sb ^ (((sb >> 9) & 1) << 5); R = (st >> 1) * 16 + swz / 64; C = (st & 1) * 32 + (swz % 64) / 2; }
__host__ __device__ __forceinline__ int perm32(int rho) { const int n = rho >> 4, i = rho & 15; return 8 * (i >> 2) + 4 * n + (i & 3); }

struct Unit { int pm, pn; };
struct Gemm { const bf16_t* A; const bf16_t* Bt; int M, N, K; };

struct StaticOrder {
    int nM, nN, nwg, G, c;
    __host__ __device__ void init(int M, int N, int G_, int c_) { nM = M / BM; nN = N / BM; nwg = nM * nN; G = G_; c = c_; }
    __host__ __device__ bool next(int i, Unit& u) const {
        const long L = (long)i * G + c; if (L >= nwg) return false;
        int wgid = (int)L; { const int q = nwg / NXCD, r = nwg % NXCD, xcd = wgid % NXCD, off = wgid / NXCD; wgid = (xcd < r ? xcd * (q + 1) : r * (q + 1) + (xcd - r) * q) + off; }
        const int nig = WGM * nN, gid = wgid / nig, fm = gid * WGM, gsz = (nM - fm) < WGM ? (nM - fm) : WGM;
        u.pm = fm + ((wgid % nig) % gsz); u.pn = (wgid % nig) / gsz; return true;
    }
    __device__ __forceinline__ void a_ready(const Unit&) const {}
    __device__ __forceinline__ void done(const Unit&) const {}
};

__device__ __forceinline__ unsigned cvt_pk_bf16(float lo, float hi) { unsigned r; asm volatile("v_cvt_pk_bf16_f32 %0, %1, %2" : "=v"(r) : "v"(lo), "v"(hi)); return r; }
typedef float f32x2 __attribute__((ext_vector_type(2)));
__device__ __forceinline__ f32x2 gelu_pk(f32x2 v) {
    const f32x2 av = __builtin_elementwise_abs(v), d = av * 0.2316418882f + 1.0f;
    f32x2 t; t.x = __builtin_amdgcn_rcpf(d.x); t.y = __builtin_amdgcn_rcpf(d.y);
    f32x2 q = t * 0.5307027145f + (-0.7265760135f); q = q * t + 0.7107068705f; q = q * t + (-0.142248368f); q = q * t + 0.127414796f; q = q * t;
    const f32x2 s = (v * v) * (-0.72134752044f);
    f32x2 e; e.x = __builtin_amdgcn_exp2f(s.x); e.y = __builtin_amdgcn_exp2f(s.y);
    const f32x2 m = v * (q * e), r = v - m;
    f32x2 o; o.x = v.x < 0.f ? m.x : r.x; o.y = v.y < 0.f ? m.y : r.y; return o;
}

template <int ACT  > struct EpiBf16 {
    static constexpr bool PERM = true, AFTER_DRAIN = false; static_assert(ACT == 0 || ACT == 1, "EpiBf16: ACT is 0 (none) or 1 (gelu_pk)");
    bf16_t* O; int ldc; const float* bias; int split_cols; size_t split_stride; float scale0;
    __device__ __forceinline__ void operator()(const f32x4 (&acc)[2][2][4][2], const Unit& u, int wr, int wc, int fr, int fq) const {
        const int row0 = u.pm * BM + wr * 64 + fr; int colt = u.pn * BM; bf16_t* base = O;
        float sc = 1.f; if (split_cols) { const int t = colt / split_cols; base += (size_t)t * split_stride; colt -= t * split_cols; if (t == 0) sc = scale0; }
        const int col0 = colt + wc * 32 + 8 * fq, bcol0 = u.pn * BM + wc * 32 + 8 * fq;
        f32x4 bv[2][2];
#pragma unroll
        for (int bj = 0; bj < 2; ++bj)
#pragma unroll
            for (int n = 0; n < 2; ++n) bv[bj][n] = bias ? *(const f32x4*)(bias + bcol0 + bj * HALF + 4 * n) : (f32x4){0.f, 0.f, 0.f, 0.f};
#pragma unroll
        for (int ai = 0; ai < 2; ++ai)
#pragma unroll
            for (int m = 0; m < 4; ++m) { bf16_t* rowp = base + (size_t)(row0 + ai * HALF + m * 16) * ldc + col0;
#pragma unroll
                for (int bj = 0; bj < 2; ++bj) { f32x4 v0 = acc[ai][bj][m][0] + bv[bj][0], v1 = acc[ai][bj][m][1] + bv[bj][1];
                    if (ACT == 1) { f32x2 a = gelu_pk((f32x2){v0[0], v0[1]}), b = gelu_pk((f32x2){v0[2], v0[3]}), c = gelu_pk((f32x2){v1[0], v1[1]}), d = gelu_pk((f32x2){v1[2], v1[3]});
                        v0 = (f32x4){a.x, a.y, b.x, b.y}; v1 = (f32x4){c.x, c.y, d.x, d.y}; }
                    v0 = v0 * sc; v1 = v1 * sc; u32x4 w; w.x = cvt_pk_bf16(v0[0], v0[1]); w.y = cvt_pk_bf16(v0[2], v0[3]); w.z = cvt_pk_bf16(v1[0], v1[1]); w.w = cvt_pk_bf16(v1[2], v1[3]);
                    *(u32x4*)(rowp + bj * HALF) = w; } }
    }
};
template <class Epi, class Sched, bool ALIGN_EPI = false, bool SP2 = false>
__device__ __forceinline__ void gemm_phase(PG8_LAS unsigned char* lds, const Gemm g, const Sched& S, const Epi& E, const int tid) {
    const int wid = __builtin_amdgcn_readfirstlane(tid >> 6), lane = tid & 63, wr = wid >> 2, wc = wid & 3, fr = lane & 15, fq = lane >> 4;
    const int K = g.K, nt = K / BK;
    unsigned voffA[2], voffB[2];
#pragma unroll
    for (int i = 0; i < 2; ++i) { int R, C; stage_rc(tid * 16 + i * 8192, R, C); const int Rb = Epi::PERM ? ((R & ~31) + perm32(R & 31)) : R;
        const int Ra = Epi::APERM ? ((R & ~63) | ((R & 15) << 2) | ((R >> 4) & 3)) : R;
        voffA[i] = (unsigned)(Ra * K + C) * 2u; voffB[i] = (unsigned)(Rb * K + C) * 2u; }
    const size_t kstep = (size_t)(BK * 2);
    const size_t hstep = (size_t)HALF * K * 2;
    const size_t tstep = 2 * hstep;
    const unsigned ldsw = (unsigned)wid * 1024u;
    const int aoff = lds_byte(wr * 64 + fr, fq * 8), boff = lds_byte(wc * 32 + fr, fq * 8);
#define PG8_SA(b, h) (((b) * 2 + (h)) * HTB)
#define PG8_SB(b, h) ((4 + (b) * 2 + (h)) * HTB)
#define PG8_STAGE(bufoff, gbase, voff) do { _Pragma("unroll") for (int _i = 0; _i < 2; ++_i) \
        __builtin_amdgcn_global_load_lds((const unsigned*)((const char*)(gbase) + (voff)[_i]), (PG8_LAS unsigned*)(lds + (bufoff) + ldsw + _i * 8192), 16, 0, 0); } while (0)
#define PG8_LDA(dst, b, h) do { _Pragma("unroll") for (int m = 0; m < 4; ++m) _Pragma("unroll") for (int k = 0; k < 2; ++k) dst[m][k] = *(const PG8_LAS bf16x8*)(lds + PG8_SA(b, h) + aoff + m * 2048 + k * 1024); } while (0)
#define PG8_LDB(dst, b, h) do { _Pragma("unroll") for (int n = 0; n < 2; ++n) _Pragma("unroll") for (int k = 0; k < 2; ++k) dst[n][k] = *(const PG8_LAS bf16x8*)(lds + PG8_SB(b, h) + boff + n * 2048 + k * 1024); } while (0)
#define PG8_MMA(ai, bj, At, Bt) do { __builtin_amdgcn_s_setprio(1); _Pragma("unroll") for (int m = 0; m < 4; ++m) _Pragma("unroll") for (int n = 0; n < 2; ++n) _Pragma("unroll") for (int k = 0; k < 2; ++k) \
        acc[ai][bj][m][n] = __builtin_amdgcn_mfma_f32_16x16x32_bf16(Bt[n][k], At[m][k], acc[ai][bj][m][n], 0, 0, 0); __builtin_amdgcn_s_setprio(0); } while (0)
#define PG8_WAIT_V(n) asm volatile("s_waitcnt vmcnt(" #n ")" ::: "memory")
#define PG8_WAIT_L(n) asm volatile("s_waitcnt lgkmcnt(" #n ")" ::: "memory")
#define PG8_BAR __builtin_amdgcn_s_barrier()
#define PG8_SCHED __builtin_amdgcn_sched_barrier(0)
    Unit cur, nxt; int ui = 0;
    if (!S.next(0, cur)) return;
    f32x4 acc[2][2][4][2];
#pragma unroll
    for (int a = 0; a < 2; ++a)
#pragma unroll
        for (int b = 0; b < 2; ++b)
#pragma unroll
            for (int m = 0; m < 4; ++m)
#pragma unroll
                for (int n = 0; n < 2; ++n) acc[a][b][m][n] = (f32x4){0.f, 0.f, 0.f, 0.f};
    bf16x8 At[4][2], B0[2][2], B1[2][2];
    const char* cA = (const char*)g.A + (size_t)cur.pm * tstep; const char* cB = (const char*)g.Bt + (size_t)cur.pn * tstep;
    S.a_ready(cur);
    if constexpr (SP2) {
        PG8_STAGE(PG8_SB(0, 0), cB, voffB); PG8_STAGE(PG8_SB(0, 1), cB + hstep, voffB); PG8_STAGE(PG8_SA(0, 0), cA, voffA); PG8_STAGE(PG8_SA(0, 1), cA + hstep, voffA);
        if (wr == 1) PG8_BAR;
        PG8_WAIT_V(2); PG8_BAR;
        PG8_STAGE(PG8_SB(1, 0), cB + kstep, voffB); PG8_STAGE(PG8_SA(1, 0), cA + kstep, voffA); PG8_STAGE(PG8_SB(1, 1), cB + hstep + kstep, voffB);
        PG8_WAIT_V(6); PG8_BAR;
    } else {
        PG8_STAGE(PG8_SB(0, 0), cB, voffB); PG8_STAGE(PG8_SA(0, 0), cA, voffA); PG8_STAGE(PG8_SB(0, 1), cB + hstep, voffB); PG8_STAGE(PG8_SA(0, 1), cA + hstep, voffA);
        if (wr == 1) PG8_BAR;
        PG8_WAIT_V(4); PG8_BAR;
        PG8_STAGE(PG8_SB(1, 0), cB + kstep, voffB); PG8_STAGE(PG8_SA(1, 0), cA + kstep, voffA); PG8_STAGE(PG8_SB(1, 1), cB + hstep + kstep, voffB);
        PG8_WAIT_V(6); PG8_BAR;
    }
    for (;;) {
        const bool has_next = S.next(ui + 1, nxt);
        const char* nA = has_next ? (const char*)g.A + (size_t)nxt.pm * tstep : cA; const char* nB = has_next ? (const char*)g.Bt + (size_t)nxt.pn * tstep : cB;
        for (int t = 0; t < nt; t += 2) {
            const bool last = (t == nt - 2);
            const char* a1 = cA + (size_t)(t + 1) * kstep;
            const char* a2 = last ? nA : cA + (size_t)(t + 2) * kstep; const char* b2 = last ? nB : cB + (size_t)(t + 2) * kstep;
            const char* a3 = a2 + kstep; const char* b3 = b2 + kstep;
            if (last && has_next) S.a_ready(nxt);
            if constexpr (SP2) {
            PG8_LDB(B0, 0, 0); PG8_LDB(B1, 0, 1); PG8_SCHED; PG8_LDA(At, 0, 0); PG8_STAGE(PG8_SA(1, 1), a1 + hstep, voffA);
            PG8_WAIT_V(8); PG8_WAIT_L(0); PG8_BAR; PG8_MMA(0, 0, At, B0); PG8_MMA(0, 1, At, B1); PG8_BAR; PG8_SCHED;
            PG8_LDA(At, 0, 1); PG8_STAGE(PG8_SB(0, 0), b2, voffB); PG8_STAGE(PG8_SB(0, 1), b2 + hstep, voffB); PG8_STAGE(PG8_SA(0, 0), a2, voffA);
            PG8_WAIT_V(8); PG8_WAIT_L(0); PG8_BAR; PG8_MMA(1, 0, At, B0); PG8_MMA(1, 1, At, B1); PG8_BAR; PG8_SCHED;
            PG8_LDB(B0, 1, 0); PG8_LDB(B1, 1, 1); PG8_SCHED; PG8_LDA(At, 1, 0); PG8_STAGE(PG8_SA(0, 1), a2 + hstep, voffA);
            PG8_WAIT_V(8); PG8_WAIT_L(0); PG8_BAR; PG8_MMA(0, 0, At, B0); PG8_MMA(0, 1, At, B1); PG8_BAR; PG8_SCHED;
            PG8_LDA(At, 1, 1); PG8_STAGE(PG8_SB(1, 0), b3, voffB); PG8_STAGE(PG8_SB(1, 1), b3 + hstep, voffB); PG8_STAGE(PG8_SA(1, 0), a3, voffA);
            PG8_WAIT_V(8); PG8_WAIT_L(0); PG8_BAR; PG8_MMA(1, 0, At, B0); PG8_MMA(1, 1, At, B1); PG8_BAR; PG8_SCHED;
            } else {
            PG8_LDB(B0, 0, 0); PG8_SCHED; PG8_LDA(At, 0, 0); PG8_STAGE(PG8_SA(1, 1), a1 + hstep, voffA);
            PG8_WAIT_L(8); PG8_BAR; PG8_WAIT_L(0); PG8_MMA(0, 0, At, B0); PG8_BAR; PG8_SCHED;
            PG8_LDB(B1, 0, 1); PG8_STAGE(PG8_SB(0, 0), b2, voffB);
            PG8_BAR; PG8_WAIT_L(0); PG8_MMA(0, 1, At, B1); PG8_BAR;
            PG8_LDA(At, 0, 1); PG8_STAGE(PG8_SA(0, 0), a2, voffA);
            PG8_BAR; PG8_WAIT_L(0); PG8_MMA(1, 0, At, B0); PG8_BAR; PG8_SCHED;
            PG8_STAGE(PG8_SB(0, 1), b2 + hstep, voffB);
            PG8_WAIT_V(6); PG8_BAR; PG8_MMA(1, 1, At, B1); PG8_BAR;
            PG8_LDB(B0, 1, 0); PG8_SCHED; PG8_LDA(At, 1, 0); PG8_STAGE(PG8_SA(0, 1), a2 + hstep, voffA);
            PG8_WAIT_L(8); PG8_BAR; PG8_WAIT_L(0); PG8_MMA(0, 0, At, B0); PG8_BAR; PG8_SCHED;
            PG8_LDB(B1, 1, 1); PG8_STAGE(PG8_SB(1, 0), b3, voffB);
            PG8_BAR; PG8_WAIT_L(0); PG8_MMA(0, 1, At, B1); PG8_BAR;
            PG8_LDA(At, 1, 1); PG8_STAGE(PG8_SA(1, 0), a3, voffA);
            PG8_BAR; PG8_WAIT_L(0); PG8_MMA(1, 0, At, B0); PG8_BAR; PG8_SCHED;
            PG8_STAGE(PG8_SB(1, 1), b3 + hstep, voffB);
            PG8_WAIT_V(6); PG8_BAR; PG8_MMA(1, 1, At, B1); PG8_BAR;
            }
        }
        if constexpr (ALIGN_EPI) { if (wr == 0) PG8_BAR; }
        if constexpr (!Epi::AFTER_DRAIN) { E(acc, cur, wr, wc, fr, fq); S.done(cur); }
        if (!has_next) break;
#pragma unroll
        for (int a = 0; a < 2; ++a)
#pragma unroll
            for (int b = 0; b < 2; ++b)
#pragma unroll
                for (int m = 0; m < 4; ++m)
#pragma unroll
                    for (int n = 0; n < 2; ++n) acc[a][b][m][n] = (f32x4){0.f, 0.f, 0.f, 0.f};
        cur = nxt; cA = nA; cB = nB; ++ui;
        if constexpr (ALIGN_EPI) { if (wr == 1) PG8_BAR; }
    }
    PG8_WAIT_V(0);
    if constexpr (!ALIGN_EPI) { if (wr == 0) PG8_BAR; }
    PG8_BAR;
    if constexpr (Epi::AFTER_DRAIN) { E.fused(acc, cur, wr, wc, fr, fq, lds, wid, lane); S.done(cur); }
#undef PG8_SA
#undef PG8_SB
#undef PG8_STAGE
#undef PG8_LDA
#undef PG8_LDB
#undef PG8_MMA
#undef PG8_WAIT_V
#undef PG8_WAIT_L
#undef PG8_BAR
#undef PG8_SCHED
}
}
#define LAS __attribute__((address_space(3)))
#define XB_TMO      128
#define XB_XCNT(j)  (256  + 64 * (j))
#define XB_XSUB(j)  (1280 + 64 * (j))
#define XB_XGEN(j)  (2304 + 64 * (j))
#define XB_TOP      3328
#define XB_TOPGEN   3392
#define XCD_BAR_WORDS 3456
#define XB_SPIN_CAP (1u << 18)

__device__ __forceinline__ unsigned xb_ld(unsigned* p)              { return __hip_atomic_load(p, __ATOMIC_RELAXED, __HIP_MEMORY_SCOPE_AGENT); }
__device__ __forceinline__ unsigned xb_add(unsigned* p, unsigned v) { return __hip_atomic_fetch_add(p, v, __ATOMIC_RELAXED, __HIP_MEMORY_SCOPE_AGENT); }
__device__ __forceinline__ unsigned xb_xcc_id() { return (unsigned)__builtin_amdgcn_s_getreg((3 << 11) | 20) & 0xFu; }
#define XB_SPIN(cond, bar) do { unsigned _sp = 0; while (cond) { __builtin_amdgcn_s_sleep(1); \
    if ((++_sp & 255u) == 0u) { if (xb_ld(&(bar)[XB_TMO])) break; if (_sp > XB_SPIN_CAP) { atomicAdd(&(bar)[XB_TMO], 1u); break; } } } } while (0)

struct XcdBarrier {
    unsigned* bar; unsigned x;
    volatile LAS unsigned* st;
};

__device__ __forceinline__ XcdBarrier xcd_barrier_post(unsigned* bar, volatile LAS unsigned* st, const int tid) {
    XcdBarrier b; b.bar = bar; b.x = xb_xcc_id(); b.st = st;
    if (tid == 0) (void)xb_add(&bar[XB_XCNT(b.x)], 1u);
    return b;
}
__device__ __forceinline__ void xcd_barrier_complete(unsigned* bar, unsigned x, unsigned& nloc, unsigned& nx) {
    const unsigned G = gridDim.x * gridDim.y * gridDim.z;
    unsigned sum, cnt, mine, sp = 0u;
    for (;;) {
        sum = 0u; cnt = 0u; mine = 0u;
#pragma unroll
        for (unsigned j = 0; j < 16; ++j) { const unsigned c = xb_ld(&bar[XB_XCNT(j)]); sum += c; cnt += (c > 0u) ? 1u : 0u; mine = (j == x) ? c : mine; }
        if (sum == G) break;
        __builtin_amdgcn_s_sleep(1);
        if ((++sp & 255u) == 0u) { if (xb_ld(&bar[XB_TMO])) break; if (sp > XB_SPIN_CAP) { atomicAdd(&bar[XB_TMO], 1u); break; } }
    }
    nloc = mine > 0u ? mine : 1u; nx = cnt > 0u ? cnt : 1u;
}

__device__ __forceinline__ void xcd_barrier(const XcdBarrier& b, const int tid) {
    asm volatile("s_waitcnt vmcnt(0)" ::: "memory");
    __syncthreads();
    if (tid == 0) {
        unsigned* bar = b.bar;
        __builtin_amdgcn_s_waitcnt(0);
        unsigned nloc = b.st[0], nx = b.st[1];
        if (nloc == 0u) { xcd_barrier_complete(bar, b.x, nloc, nx); b.st[0] = nloc; b.st[1] = nx; }
        const unsigned old = xb_add(&bar[XB_XSUB(b.x)], 1u);
        const unsigned gen = old / nloc;
        if (old + 1u == (gen + 1u) * nloc) {
            __builtin_amdgcn_fence(__ATOMIC_RELEASE, "agent");
            asm volatile("s_waitcnt vmcnt(0)" ::: "memory");
            const unsigned og = xb_add(&bar[XB_TOP], 1u);
            const unsigned tg = og / nx;
            if (og + 1u == (tg + 1u) * nx) xb_add(&bar[XB_TOPGEN], 1u);
            else XB_SPIN(xb_ld(&bar[XB_TOPGEN]) == tg, bar);
            __builtin_amdgcn_fence(__ATOMIC_ACQUIRE, "agent");
            xb_add(&bar[XB_XGEN(b.x)], 1u);
            asm volatile("s_waitcnt vmcnt(0)" ::: "memory");
        } else {
            XB_SPIN(xb_ld(&bar[XB_XGEN(b.x)]) == gen, bar);
            __builtin_amdgcn_fence(__ATOMIC_ACQUIRE, "agent");
            asm volatile("s_waitcnt vmcnt(0)" ::: "memory");
        }
    }
    __syncthreads();
}
#ifndef PG8_SP2
#define PG8_SP2 true
#endif
#ifndef PG8_ALIGN
#define PG8_ALIGN true
#endif
#ifndef NLAYERS
#define NLAYERS 4
#endif
#ifndef MK_SINGLE
#define MK_SINGLE 1
#endif
namespace cg = cooperative_groups;
#define LAS __attribute__((address_space(3)))
typedef unsigned short bf16;
typedef float f32x4 __attribute__((ext_vector_type(4)));
typedef float f32x2 __attribute__((ext_vector_type(2)));
typedef short bf16x8 __attribute__((ext_vector_type(8)));
typedef unsigned u32x4 __attribute__((ext_vector_type(4)));
typedef unsigned u32x2 __attribute__((ext_vector_type(2)));

__device__ __forceinline__ void xcd_arrive(const XcdBarrier& b, const int tid) {
    asm volatile("s_waitcnt vmcnt(0)" ::: "memory");
    __syncthreads();
    if (tid == 0) {
        unsigned* bar = b.bar;
        __builtin_amdgcn_s_waitcnt(0);
        unsigned nloc = b.st[0], nx = b.st[1];
        if (nloc == 0u) { xcd_barrier_complete(bar, b.x, nloc, nx); b.st[0] = nloc; b.st[1] = nx; }
        const unsigned old = xb_add(&bar[XB_XSUB(b.x)], 1u);
        const unsigned gen = old / nloc;
        b.st[2] = gen;
        if (old + 1u == (gen + 1u) * nloc) {
            __builtin_amdgcn_fence(__ATOMIC_RELEASE, "agent");
            asm volatile("s_waitcnt vmcnt(0)" ::: "memory");
            (void)xb_add(&bar[XB_XGEN(b.x)], 1u);
            asm volatile("s_waitcnt vmcnt(0)" ::: "memory");
            const unsigned og = xb_add(&bar[XB_TOP], 1u);
            const unsigned tg = og / nx;
            if (og + 1u == (tg + 1u) * nx) xb_add(&bar[XB_TOPGEN], 1u);
        }
    }
    __syncthreads();
}
__device__ __forceinline__ void xcd_wait(const XcdBarrier& b, const int tid) {
    __syncthreads();
    if (tid == 0) {
        unsigned* bar = b.bar;
        const unsigned gen = b.st[2];
        XB_SPIN(xb_ld(&bar[XB_TOPGEN]) <= gen, bar);
        __builtin_amdgcn_fence(__ATOMIC_ACQUIRE, "agent");
        asm volatile("s_waitcnt vmcnt(0)" ::: "memory");
    }
    __syncthreads();
}
constexpr int NTHR = 512;
constexpr int BATCH = 2, SEQ = 8192, D = 1024, M = BATCH * SEQ, DEPTH = 4;
constexpr int NIN = 2592, NINP = 2816, FF = 2816, NUP = 5632;
constexpr float EPS = 1e-6f;
constexpr int NPHASE = 1 + 8 * DEPTH;
constexpr size_t MiB = 1u << 20;
constexpr size_t WS_WIN = 2 * MiB, WS_WOUT = 8 * MiB, WS_WUP = 10 * MiB, WS_WDOWN = 21 * MiB;
constexpr size_t WS_R1 = 28 * MiB;
constexpr size_t WS_P = WS_R1, WS_MIX = WS_R1 + 88 * MiB, WS_DS = WS_R1 + 120 * MiB, WS_ST = WS_R1 + 152 * MiB, WS_DEC = WS_R1 + 168 * MiB;
constexpr size_t WS_R2 = 204 * MiB;
constexpr size_t WS_CUM = WS_R2;
constexpr size_t WS_XB = 292 * MiB;
constexpr size_t WS_END = 324 * MiB;
constexpr size_t WS_SSM = 1024 * 1024, WS_SSF = WS_SSM + 256 * 1024;
constexpr size_t WS_XN2 = WS_MIX;
constexpr int LDS_BYTES = 131072 + 16384 + 64, MISC_OFF = LDS_BYTES - 64, XL_OFF = 131072;
constexpr int CW_PCNT = 8192;
constexpr int CW_BAR = 4096;
constexpr size_t CTL_ZERO_BYTES = 65536;
constexpr int LDT = 136, LDK = 72;
constexpr int MB0 = 0, MB1 = 34816, MB2 = 69632, MB3 = 104448;
constexpr int RBUF_OFF = MB1, TOT_OFF = MB1 + 16384;

struct Args { const float* in[19]; float* out; unsigned char* ws; int ph_lo, ph_hi; };

__device__ __forceinline__ unsigned pk2(float lo, float hi) { return pg8::cvt_pk_bf16(lo, hi); }
__device__ __forceinline__ float bf_lo(unsigned u) { return __uint_as_float(u << 16); }
__device__ __forceinline__ float bf_hi(unsigned u) { return __uint_as_float(u & 0xffff0000u); }
__device__ __forceinline__ unsigned f2bf(float f) { unsigned u = __float_as_uint(f); return (u + 0x7fffu + ((u >> 16) & 1u)) >> 16; }
__device__ __forceinline__ float wave_sum(float v) {
#pragma unroll
    for (int o = 1; o < 64; o <<= 1) v += __shfl_xor(v, o);
    return v;
}
template <int CTRL, int ROWMASK, bool BC> __device__ __forceinline__ float dpp_add(float v) { return v + __int_as_float(__builtin_amdgcn_update_dpp(0, __float_as_int(v), CTRL, ROWMASK, 0xf, BC)); }
__device__ __forceinline__ float wave_sum_dpp(float v) {
    v = dpp_add<0x111, 0xf, true>(v); v = dpp_add<0x112, 0xf, true>(v); v = dpp_add<0x114, 0xf, true>(v); v = dpp_add<0x118, 0xf, true>(v);
    v = dpp_add<0x142, 0xa, false>(v); v = dpp_add<0x143, 0xc, false>(v);
    return __int_as_float(__builtin_amdgcn_readlane(__float_as_int(v), 63));
}
__device__ __forceinline__ float silu_f(float x) { return x * __frcp_rn(1.f + __expf(-x)); }
__device__ __forceinline__ f32x4 silu4(f32x4 x) {
    const f32x4 a = x * (-1.44269504089f);
    f32x4 e; e[0] = __builtin_amdgcn_exp2f(a[0]); e[1] = __builtin_amdgcn_exp2f(a[1]); e[2] = __builtin_amdgcn_exp2f(a[2]); e[3] = __builtin_amdgcn_exp2f(a[3]);
    const f32x4 d = e + 1.f;
    f32x4 r; r[0] = __builtin_amdgcn_rcpf(d[0]); r[1] = __builtin_amdgcn_rcpf(d[1]); r[2] = __builtin_amdgcn_rcpf(d[2]); r[3] = __builtin_amdgcn_rcpf(d[3]);
    return x * r;
}
__device__ __forceinline__ f32x2 logsig2_log2_16(f32x2 x) {
    const f32x2 a = __builtin_elementwise_abs(x) * (-1.44269504089f);
    f32x2 e; e.x = __builtin_amdgcn_exp2f(a.x); e.y = __builtin_amdgcn_exp2f(a.y);
    const f32x2 d = e + 1.f;
    f32x2 lg; lg.x = __builtin_amdgcn_logf(d.x); lg.y = __builtin_amdgcn_logf(d.y);
    return __builtin_elementwise_min(x, (f32x2){0.f, 0.f}) * (0.0625f * 1.44269504089f) - lg * 0.0625f;
}
__device__ __forceinline__ float logsig_f(float x) { return fminf(x, 0.f) - __logf(1.f + __expf(-fabsf(x))); }

__device__ __forceinline__ float lds_rstd(const LAS unsigned char* slot, int rowlocal) { const f32x4 p = *(const LAS f32x4*)(slot + 4096 + rowlocal * 16); return rsqrtf(((p[0] + p[1]) + (p[2] + p[3])) * (1.f / D) + EPS); }
__device__ __forceinline__ float row_rstd(const float* ssp, int row) { const f32x4 p = *(const f32x4*)(ssp + (size_t)row * 4); return rsqrtf(((p[0] + p[1]) + (p[2] + p[3])) * (1.f / D) + EPS); }
struct EpiIn {
    static constexpr bool PERM = true, AFTER_DRAIN = false, APERM = false;
    bf16* O; LAS unsigned char* xl; mutable int cnt;
    __device__ __forceinline__ void operator()(const f32x4 (&acc)[2][2][4][2], const pg8::Unit& u, int wr, int wc, int fr, int fq) const {
        const int row0 = u.pm * 256 + wr * 64 + fr, col0 = u.pn * 256 + wc * 32 + 8 * fq;
        const LAS unsigned char* slot = xl + (cnt & 1) * 8192; ++cnt;
        if (u.pn * 256 + wc * 32 >= NIN) return;
        const bool act = u.pn < 4; const float sc = (u.pn == 4) ? 0.125f : 1.f;
        float rsa[2][4];
#pragma unroll
        for (int ai = 0; ai < 2; ++ai)
#pragma unroll
            for (int m = 0; m < 4; ++m) rsa[ai][m] = lds_rstd(slot, ai * 128 + wr * 64 + m * 16 + fr) * (act ? 1.f : sc);
#pragma unroll
        for (int ai = 0; ai < 2; ++ai)
#pragma unroll
            for (int m = 0; m < 4; ++m) { const int row = row0 + ai * 128 + m * 16; bf16* rowp = O + (size_t)row * NINP + col0;
                const float rs = rsa[ai][m];
#pragma unroll
                for (int bj = 0; bj < 2; ++bj) { f32x4 v0 = acc[ai][bj][m][0] * rs, v1 = acc[ai][bj][m][1] * rs;
                    if (act) { f32x2 a = pg8::gelu_pk((f32x2){v0[0], v0[1]}), b = pg8::gelu_pk((f32x2){v0[2], v0[3]}), c = pg8::gelu_pk((f32x2){v1[0], v1[1]}), d = pg8::gelu_pk((f32x2){v1[2], v1[3]});
                        v0 = (f32x4){a.x, a.y, b.x, b.y}; v1 = (f32x4){c.x, c.y, d.x, d.y}; }
                    u32x4 w; w.x = pk2(v0[0], v0[1]); w.y = pk2(v0[2], v0[3]); w.z = pk2(v1[0], v1[1]); w.w = pk2(v1[2], v1[3]);
                    *(u32x4*)(rowp + bj * 128) = w; } }
    }
};
struct EpiUp {
    static constexpr bool PERM = true, AFTER_DRAIN = false;
    bf16* O; const float* ss;
    __device__ __forceinline__ void operator()(const f32x4 (&acc)[2][2][4][2], const pg8::Unit& u, int wr, int wc, int fr, int fq) const {
        const int row0 = u.pm * 256 + wr * 64 + fr, col0 = u.pn * 256 + wc * 32 + 8 * fq;
#pragma unroll
        for (int ai = 0; ai < 2; ++ai)
#pragma unroll
            for (int m = 0; m < 4; ++m) { const int row = row0 + ai * 128 + m * 16; bf16* rowp = O + (size_t)row * NUP + col0;
                const float rs = row_rstd(ss, row);
#pragma unroll
                for (int bj = 0; bj < 2; ++bj) { const f32x4 v0 = acc[ai][bj][m][0] * rs, v1 = acc[ai][bj][m][1] * rs;
                    u32x4 w; w.x = pk2(v0[0], v0[1]); w.y = pk2(v0[2], v0[3]); w.z = pk2(v1[0], v1[1]); w.w = pk2(v1[2], v1[3]);
                    *(u32x4*)(rowp + bj * 128) = w; } }
    }
};
template <bool LAST>
struct EpiRes16 {
    static constexpr bool PERM = true, AFTER_DRAIN = true, APERM = false;
    bf16* xb; float* out; float* ssp; const float* gfin; unsigned* pcnt;
    __device__ __forceinline__ void fused(f32x4 (&acc)[2][2][4][2], const pg8::Unit& u, int wr, int wc, int fr, int fq, PG8_LAS unsigned char* lds, int wid, int lane) const {
        const int row0 = u.pm * 256 + wr * 64 + fr, col0 = u.pn * 256 + wc * 32 + 8 * fq;
        PG8_LAS float* part = (PG8_LAS float*)lds;
        PG8_LAS float* rtab = (PG8_LAS float*)(lds + 4096);
        u32x4 xva[2][4][2];
#pragma unroll
        for (int ai = 0; ai < 2; ++ai)
#pragma unroll
            for (int m = 0; m < 4; ++m)
#pragma unroll
                for (int bj = 0; bj < 2; ++bj) xva[ai][m][bj] = *(const u32x4*)(xb + (size_t)(row0 + ai * 128 + m * 16) * D + col0 + bj * 128);
        f32x4 gq[2][2];
        if (LAST) {
#pragma unroll
            for (int bj = 0; bj < 2; ++bj) { gq[bj][0] = *(const f32x4*)(gfin + col0 + bj * 128); gq[bj][1] = *(const f32x4*)(gfin + col0 + bj * 128 + 4); } }
#pragma unroll
        for (int ai = 0; ai < 2; ++ai)
#pragma unroll
            for (int m = 0; m < 4; ++m) { const int row = row0 + ai * 128 + m * 16; const size_t off = (size_t)row * D + col0; float sq = 0.f;
#pragma unroll
                for (int bj = 0; bj < 2; ++bj) { const u32x4 xv = xva[ai][m][bj];
                    const f32x4 x0 = (f32x4){bf_lo(xv.x), bf_hi(xv.x), bf_lo(xv.y), bf_hi(xv.y)} + acc[ai][bj][m][0], x1 = (f32x4){bf_lo(xv.z), bf_hi(xv.z), bf_lo(xv.w), bf_hi(xv.w)} + acc[ai][bj][m][1];
                    sq += ((x0[0] * x0[0] + x0[1] * x0[1]) + (x0[2] * x0[2] + x0[3] * x0[3])) + ((x1[0] * x1[0] + x1[1] * x1[1]) + (x1[2] * x1[2] + x1[3] * x1[3]));
                    if (LAST) { acc[ai][bj][m][0] = x0; acc[ai][bj][m][1] = x1; }
                    else *(u32x4*)(xb + off + bj * 128) = (u32x4){pk2(x0[0], x0[1]), pk2(x0[2], x0[3]), pk2(x1[0], x1[1]), pk2(x1[2], x1[3])}; }
                sq += __shfl_xor(sq, 16); sq += __shfl_xor(sq, 32);
                if (fq == 0) part[(ai * 128 + wr * 64 + m * 16 + fr) * 4 + wc] = sq; }
        asm volatile("s_waitcnt lgkmcnt(0)" ::: "memory"); __builtin_amdgcn_s_barrier(); asm volatile("" ::: "memory");
        const int t = wid * 64 + lane;
        float own = 0.f;
        if (t < 256) { const f32x4 p = *(const PG8_LAS f32x4*)(part + t * 4); own = (p[0] + p[1]) + (p[2] + p[3]); }
        if (!LAST) { if (t < 256) ssp[(size_t)(u.pm * 256 + t) * 4 + u.pn] = own; }
        else {
            if (t < 256) __hip_atomic_store(ssp + (size_t)(u.pm * 256 + t) * 4 + u.pn, own, __ATOMIC_RELAXED, __HIP_MEMORY_SCOPE_AGENT);
            asm volatile("s_waitcnt vmcnt(0)" ::: "memory");
            if (wid < 4 && lane == 0) __hip_atomic_fetch_add(pcnt + 64 * u.pm, 1u, __ATOMIC_RELAXED, __HIP_MEMORY_SCOPE_AGENT);
            if (wid == 0) {
                for (unsigned sp = 0; sp < (1u << 20); ++sp) {
                    if ((unsigned)__builtin_amdgcn_readfirstlane((int)__hip_atomic_load(pcnt + 64 * u.pm, __ATOMIC_RELAXED, __HIP_MEMORY_SCOPE_AGENT)) >= 16u) break;
                    __builtin_amdgcn_s_sleep(2);
                }
                __builtin_amdgcn_fence(__ATOMIC_ACQUIRE, "agent");
            }
            asm volatile("s_waitcnt vmcnt(0) lgkmcnt(0)" ::: "memory"); __builtin_amdgcn_s_barrier(); asm volatile("" ::: "memory");
            if (t < 256) { const float* sp4 = ssp + (size_t)(u.pm * 256 + t) * 4; float q4[4];
#pragma unroll
                for (int k = 0; k < 4; ++k) q4[k] = __hip_atomic_load(sp4 + k, __ATOMIC_RELAXED, __HIP_MEMORY_SCOPE_AGENT);
                rtab[t] = rsqrtf(((q4[0] + q4[1]) + (q4[2] + q4[3])) * (1.f / D) + EPS); }
            asm volatile("s_waitcnt vmcnt(0) lgkmcnt(0)" ::: "memory"); __builtin_amdgcn_s_barrier(); asm volatile("" ::: "memory");
#pragma unroll
            for (int ai = 0; ai < 2; ++ai)
#pragma unroll
                for (int m = 0; m < 4; ++m) { const float rs = rtab[ai * 128 + wr * 64 + m * 16 + fr]; const size_t off = (size_t)(row0 + ai * 128 + m * 16) * D + col0;
#pragma unroll
                    for (int bj = 0; bj < 2; ++bj) { *(f32x4*)(out + off + bj * 128) = acc[ai][bj][m][0] * rs * gq[bj][0]; *(f32x4*)(out + off + bj * 128 + 4) = acc[ai][bj][m][1] * rs * gq[bj][1]; } }
        }
    }
};

struct PrefetchOrder : pg8::StaticOrder {
    const float* ssp; const float* cw; const float* cb; LAS unsigned char* xl; int tid; mutable int cnt;
    __device__ __forceinline__ void a_ready(const pg8::Unit& u) const {
        LAS unsigned char* dst = xl + (cnt & 1) * 8192; ++cnt;
        const int wv = __builtin_amdgcn_readfirstlane(tid >> 6), ln = tid & 63;
        if (wv < 4) {
            if (cw) { const int run = 2 * wv + (ln >> 5), k = run & 3, half = run >> 2;
                const float* src = (k < 3 ? cw + (size_t)k * NUP : cb) + half * FF + u.pn * 128 + (ln & 31) * 4;
                __builtin_amdgcn_global_load_lds((const unsigned*)src, (LAS unsigned*)(dst + wv * 1024), 16, 0, 0); }
        } else {
            const float* src = ssp + (size_t)(u.pm * 256 + (wv - 4) * 64 + ln) * 4;
            __builtin_amdgcn_global_load_lds((const unsigned*)src, (LAS unsigned*)(dst + 4096 + (wv - 4) * 1024), 16, 0, 0);
        }
    }
};
constexpr int DPP_SHR1 = 0x111, DPP_SHL1 = 0x101, DPP_ROR1 = 0x121, DPP_ROR15 = 0x12F;
template <int CTRL> __device__ __forceinline__ float dpp0(float v) { return __int_as_float(__builtin_amdgcn_update_dpp(0, __float_as_int(v), CTRL, 0xf, 0xf, true)); }
__device__ __forceinline__ float dpp_prev(float cur, float grp_below) {
    const int t = __builtin_amdgcn_update_dpp(0, __float_as_int(grp_below), DPP_ROR1, 0xf, 0xf, false);
    return __int_as_float(__builtin_amdgcn_update_dpp(t, __float_as_int(cur), DPP_SHR1, 0xf, 0xf, false)); }
__device__ __forceinline__ float dpp_next(float cur, float grp_above) {
    const int t = __builtin_amdgcn_update_dpp(0, __float_as_int(grp_above), DPP_ROR15, 0xf, 0xf, false);
    return __int_as_float(__builtin_amdgcn_update_dpp(t, __float_as_int(cur), DPP_SHL1, 0xf, 0xf, false)); }
struct EpiUpConv {
    static constexpr bool PERM = false, AFTER_DRAIN = false, APERM = true;
    bf16* ACT; bf16* YB; LAS unsigned char* xl; mutable int cnt;
    __device__ __forceinline__ void operator()(const f32x4 (&acc)[2][2][4][2], const pg8::Unit& u, int wr, int wc, int fr, int fq) const {
        const int cg0 = wc * 32 + 4 * fq, jg0 = u.pn * 128 + cg0;
        const LAS unsigned char* slot = xl + (cnt & 1) * 8192; ++cnt;
        float rs[2][4];
#pragma unroll
        for (int ai = 0; ai < 2; ++ai)
#pragma unroll
            for (int m = 0; m < 4; ++m) rs[ai][m] = lds_rstd(slot, ai * 128 + wr * 64 + 4 * fr + m);
#pragma unroll
        for (int n = 0; n < 2; ++n) {
            const int jg = jg0 + 16 * n;
            const LAS unsigned char* wl = slot + (cg0 + 16 * n) * 4;
            const f32x4 wg0 = *(const LAS f32x4*)(wl), wg1 = *(const LAS f32x4*)(wl + 512), wg2 = *(const LAS f32x4*)(wl + 1024), bg = *(const LAS f32x4*)(wl + 1536);
            const f32x4 wv0 = *(const LAS f32x4*)(wl + 2048), wv1 = *(const LAS f32x4*)(wl + 2560), wv2 = *(const LAS f32x4*)(wl + 3072), bv = *(const LAS f32x4*)(wl + 3584);
#pragma unroll
            for (int ai = 0; ai < 2; ++ai) {
                f32x4 Gv[4], Vv[4];
#pragma unroll
                for (int m = 0; m < 4; ++m) { Gv[m] = acc[ai][0][m][n] * rs[ai][m]; Vv[m] = acc[ai][1][m][n] * rs[ai][m]; }
                const int blk = u.pm * 4 + ai * 2 + wr;
                bf16* ybp = YB + (size_t)(blk * 4) * NUP + u.pn * 256 + cg0 + 16 * n;
                if (fr == 0) {
#pragma unroll
                    for (int q = 0; q < 2; ++q) { bf16* p = ybp + (size_t)q * NUP; *(u32x2*)p = (u32x2){pk2(Gv[q][0], Gv[q][1]), pk2(Gv[q][2], Gv[q][3])}; *(u32x2*)(p + 128) = (u32x2){pk2(Vv[q][0], Vv[q][1]), pk2(Vv[q][2], Vv[q][3])}; } }
                if (fr == 15) {
#pragma unroll
                    for (int q = 2; q < 4; ++q) { bf16* p = ybp + (size_t)q * NUP; *(u32x2*)p = (u32x2){pk2(Gv[q][0], Gv[q][1]), pk2(Gv[q][2], Gv[q][3])}; *(u32x2*)(p + 128) = (u32x2){pk2(Vv[q][0], Vv[q][1]), pk2(Vv[q][2], Vv[q][3])}; } }
                f32x4 gpre, gnxt, vpre, vnxt;
#pragma unroll
                for (int c = 0; c < 4; ++c) { gpre[c] = dpp0<DPP_SHR1>(Gv[3][c]); gnxt[c] = dpp0<DPP_SHL1>(Gv[0][c]); vpre[c] = dpp0<DPP_SHR1>(Vv[3][c]); vnxt[c] = dpp0<DPP_SHL1>(Vv[0][c]); }
#pragma unroll
                for (int m = 0; m < 4; ++m) {
                    const f32x4 gp = m > 0 ? Gv[m > 0 ? m - 1 : 0] : gpre, gn = m < 3 ? Gv[m < 3 ? m + 1 : 3] : gnxt;
                    const f32x4 vp = m > 0 ? Vv[m > 0 ? m - 1 : 0] : vpre, vn = m < 3 ? Vv[m < 3 ? m + 1 : 3] : vnxt;
                    const f32x4 zg = bg + gp * wg0 + Gv[m] * wg1 + gn * wg2;
                    const f32x4 zv = bv + vp * wv0 + Vv[m] * wv1 + vn * wv2;
                    const f32x4 ov4 = silu4(zg) * zv; const float o0 = ov4[0], o1 = ov4[1], o2 = ov4[2], o3 = ov4[3];
                    const int row = u.pm * 256 + ai * 128 + wr * 64 + 4 * fr + m;
                    *(u32x2*)(ACT + (size_t)row * FF + jg) = (u32x2){pk2(o0, o1), pk2(o2, o3)};
                }
            }
        }
    }
};
__device__ __forceinline__ void transpose_item(const float* W, int K, int N, bf16* WT, LAS float* scr, int item, int lane, const float* gk = nullptr, const bool up_perm = false) {
    const int nblk = N / 32, kb = item / nblk, nb = item % nblk, k0 = 64 * kb, n0 = 32 * nb;
    const int r0 = !up_perm ? n0 : (n0 < FF ? 256 * (n0 >> 7) + (n0 & 127) : 256 * ((n0 - FF) >> 7) + 128 + ((n0 - FF) & 127));
    {
        const int rr = lane >> 3, c4 = (lane & 7) * 4;
        f32x4 v[8]; float gs[8];
#pragma unroll
        for (int i = 0; i < 8; ++i) { v[i] = *(const f32x4*)(W + (size_t)(k0 + rr + 8 * i) * N + n0 + c4); gs[i] = gk ? gk[k0 + rr + 8 * i] : 1.f; }
#pragma unroll
        for (int i = 0; i < 8; ++i) { LAS float* d = scr + (rr + 8 * i) * 33 + c4; d[0] = v[i][0] * gs[i]; d[1] = v[i][1] * gs[i]; d[2] = v[i][2] * gs[i]; d[3] = v[i][3] * gs[i]; }
    }
    asm volatile("s_waitcnt lgkmcnt(0)" ::: "memory");
    const int c = lane & 7;
#pragma unroll
    for (int j = 0; j < 4; ++j) { const int n = (lane >> 3) + 8 * j; const LAS float* s = scr + (8 * c) * 33 + n;
        u32x4 o; o.x = pk2(s[0 * 33], s[1 * 33]); o.y = pk2(s[2 * 33], s[3 * 33]); o.z = pk2(s[4 * 33], s[5 * 33]); o.w = pk2(s[6 * 33], s[7 * 33]);
        *(u32x4*)(WT + (size_t)(r0 + n) * K + k0 + 8 * c) = o; }
    asm volatile("s_waitcnt lgkmcnt(0)" ::: "memory");
}
__device__ __forceinline__ void convert_weights(const Args& a, int l, int which, LAS unsigned char* lds, int gw, int NGW, int wave, int lane) {
    LAS float* scr = (LAS float*)(lds + wave * 16384);
    const float* Win = a.in[2] + (size_t)l * D * NIN; const float* Wout = a.in[12] + (size_t)l * D * D;
    const float* Wup = a.in[14] + (size_t)l * D * NUP; const float* Wdn = a.in[17] + (size_t)l * FF * D;
    bf16* Win_t = (bf16*)(a.ws + WS_WIN); bf16* Wout_t = (bf16*)(a.ws + WS_WOUT); bf16* Wup_t = (bf16*)(a.ws + WS_WUP); bf16* Wdn_t = (bf16*)(a.ws + WS_WDOWN);
    constexpr int I_IN = (D / 64) * (NIN / 32), I_OUT = (D / 64) * (D / 32), I_UP = (D / 64) * (NUP / 32), I_DN = (FF / 64) * (D / 32);
    if (which & 1) {
        for (int it = gw; it < I_IN + I_OUT; it += NGW) {
            if (it < I_IN) transpose_item(Win, D, NIN, Win_t, scr, it, lane, a.in[1] + (size_t)l * D);
            else transpose_item(Wout, D, D, Wout_t, scr, it - I_IN, lane);
        }
        u32x4* pad = (u32x4*)(Win_t + (size_t)NIN * D);
        for (int i = gw * 64 + lane; i < (NINP - NIN) * D / 8; i += NGW * 64) pad[i] = (u32x4){0u, 0u, 0u, 0u};
    }
    if (which & 4) for (int it = gw; it < I_UP; it += NGW) transpose_item(Wup, D, NUP, Wup_t, scr, it, lane, a.in[13] + (size_t)l * D, true);
    if (which & 2) for (int it = gw; it < I_DN; it += NGW) transpose_item(Wdn, FF, D, Wdn_t, scr, it, lane);
}
__device__ __forceinline__ void prologue_rows(const float* X, const float* g, bf16* XN, float* ss, int gw, int NGW, int lane) {
    f32x4 gv[4];
#pragma unroll
    for (int j = 0; j < 4; ++j) gv[j] = ((const f32x4*)g)[lane + 64 * j];
    for (int m = gw; m < M; m += NGW) {
        const f32x4* xr = (const f32x4*)(X + (size_t)m * D) + lane; f32x4 v[4]; float s = 0.f;
#pragma unroll
        for (int j = 0; j < 4; ++j) { v[j] = xr[64 * j]; s += (v[j].x * v[j].x + v[j].y * v[j].y) + (v[j].z * v[j].z + v[j].w * v[j].w); }
        s = wave_sum(s);
        if (lane == 0) *(f32x4*)(ss + (size_t)m * 4) = (f32x4){s, 0.f, 0.f, 0.f};
        unsigned long long* o8 = (unsigned long long*)(XN + (size_t)m * D) + lane;
#pragma unroll
        for (int j = 0; j < 4; ++j) { const f32x4 y = v[j]; o8[64 * j] = (unsigned long long)pk2(y.x, y.y) | ((unsigned long long)pk2(y.z, y.w) << 32); }
    }
}
__device__ __forceinline__ void final_rows(float* X, const float* g, const float* ss, int gw, int NGW, int lane) {
    f32x4 gv[4];
#pragma unroll
    for (int j = 0; j < 4; ++j) gv[j] = ((const f32x4*)g)[lane + 64 * j];
    for (int m = gw; m < M; m += NGW) {
        f32x4* xr = (f32x4*)(X + (size_t)m * D) + lane; const float rstd = row_rstd(ss, m);
#pragma unroll
        for (int j = 0; j < 4; ++j) xr[64 * j] = xr[64 * j] * rstd * gv[j];
    }
}
#define LBAR() do { asm volatile("s_waitcnt lgkmcnt(0)" ::: "memory"); __builtin_amdgcn_s_barrier(); asm volatile("" ::: "memory"); } while (0)
template <int NT, int KS>
__device__ __forceinline__ void mma_rc(const LAS bf16* X, int ldx, int r0, const LAS bf16* Y, int ldy, int c0, f32x4 (&acc)[NT], int lane) {
    const int fr = lane & 15, fq = lane >> 4;
    const LAS bf16* yp = Y + (c0 + fr) * ldy + fq * 8;
    const LAS bf16* xp = X + (r0 + fr) * ldx + fq * 8;
#pragma unroll
    for (int ks = 0; ks < KS; ++ks) {
        const bf16x8 b = *(const LAS bf16x8*)(yp + ks * 32);
#pragma unroll
        for (int t = 0; t < NT; ++t) {
            const bf16x8 a = *(const LAS bf16x8*)(xp + t * 16 * ldx + ks * 32);
            acc[t] = __builtin_amdgcn_mfma_f32_16x16x32_bf16(a, b, acc[t], 0, 0, 0);
        }
    }
}
__device__ __forceinline__ void stage_rbuf(const bf16* P, int row0, LAS unsigned char* lds, int tid) {
    const int r = tid >> 2, part = tid & 3;
    const u32x4 v = *(const u32x4*)(P + (size_t)(row0 + r) * NINP + 2560 + part * 8);
    LAS f32x4* dst = (LAS f32x4*)(lds + RBUF_OFF + (r * 32 + part * 8) * 4);
    dst[0] = (f32x4){bf_lo(v.x), bf_hi(v.x), bf_lo(v.y), bf_hi(v.y)};
    dst[1] = (f32x4){bf_lo(v.z), bf_hi(v.z), bf_lo(v.w), bf_hi(v.w)};
}
template <bool LN>
__device__ __forceinline__ void stage_T(const bf16* P, int row0, int col0, LAS unsigned char* buf, int wave, int lane, const float* lng, const float* lnb) {
    float a[16], b[16];
    const bf16* src = P + (size_t)(row0 + 16 * wave) * NINP + col0 + 2 * lane;
#pragma unroll
    for (int s = 0; s < 16; ++s) { const unsigned v = *(const unsigned*)(src + (size_t)s * NINP); a[s] = bf_lo(v); b[s] = bf_hi(v); }
    if (LN) {
        const f32x2 g = *(const f32x2*)(lng + 2 * lane), bb = *(const f32x2*)(lnb + 2 * lane);
#pragma unroll
        for (int s = 0; s < 16; ++s) {
            const float mu = wave_sum(a[s] + b[s]) * (1.f / 128.f);
            const float da = a[s] - mu, db = b[s] - mu;
            const float rstd = rsqrtf(wave_sum(da * da + db * db) * (1.f / 128.f) + EPS);
            a[s] = da * rstd * g.x + bb.x; b[s] = db * rstd * g.y + bb.y;
        }
    }
    LAS u32x4* d0 = (LAS u32x4*)(buf + ((2 * lane) * LDT + 16 * wave) * 2);
    LAS u32x4* d1 = (LAS u32x4*)(buf + ((2 * lane + 1) * LDT + 16 * wave) * 2);
    d0[0] = (u32x4){pk2(a[0], a[1]), pk2(a[2], a[3]), pk2(a[4], a[5]), pk2(a[6], a[7])};
    d0[1] = (u32x4){pk2(a[8], a[9]), pk2(a[10], a[11]), pk2(a[12], a[13]), pk2(a[14], a[15])};
    d1[0] = (u32x4){pk2(b[0], b[1]), pk2(b[2], b[3]), pk2(b[4], b[5]), pk2(b[6], b[7])};
    d1[1] = (u32x4){pk2(b[8], b[9]), pk2(b[10], b[11]), pk2(b[12], b[13]), pk2(b[14], b[15])};
}
struct CumState { float cf[2][8], cb[2][8], tf[2], tb[2]; };
__device__ __forceinline__ void gate_dir(const float* wg, const float* bgp, const LAS unsigned char* rb, float (&la)[2][8]) {
    f32x2 wv[16];
#pragma unroll
    for (int t = 0; t < 16; ++t) wv[t] = *(const f32x2*)(wg + t * 256);
    const f32x2 bv = *(const f32x2*)bgp;
#pragma unroll
    for (int s = 0; s < 8; ++s) {
        const LAS f32x4* r = (const LAS f32x4*)(rb + s * 128);
        f32x2 pp = bv;
#pragma unroll
        for (int q = 0; q < 4; ++q) { const f32x4 rv = r[q];
#pragma unroll
            for (int e = 0; e < 4; ++e) pp = __builtin_elementwise_fma((f32x2){rv[e], rv[e]}, wv[4 * q + e], pp); }
        { const f32x2 l2 = logsig2_log2_16(pp); la[0][s] = l2.x; la[1][s] = l2.y; }
        if (s & 1) __builtin_amdgcn_sched_barrier(0);
    }
}
__device__ __forceinline__ void compute_cum(const Args& a, int l, int h, LAS unsigned char* lds, int wave, int lane, CumState& C) {
    const int p = lane & 31, seg = 2 * wave + (lane >> 5);
    const int co = l * 256 + h * 64 + 2 * p;
    const LAS unsigned char* rb = lds + RBUF_OFF + (8 * seg) * 128;
    gate_dir(a.in[7] + (size_t)l * 16 * 256 + h * 64 + 2 * p, a.in[8] + co, rb, C.cf);
    { float r0 = 0.f, r1 = 0.f;
#pragma unroll
      for (int s = 0; s < 8; ++s) { r0 += C.cf[0][s]; r1 += C.cf[1][s]; C.cf[0][s] = r0; C.cf[1][s] = r1; } }
    __builtin_amdgcn_sched_barrier(0);
    gate_dir(a.in[9] + (size_t)l * 16 * 256 + h * 64 + 2 * p, a.in[10] + co, rb + 64, C.cb);
    { float r0 = 0.f, r1 = 0.f;
#pragma unroll
      for (int s = 7; s >= 0; --s) { r0 += C.cb[0][s]; r1 += C.cb[1][s]; C.cb[0][s] = r0; C.cb[1][s] = r1; } }
    __builtin_amdgcn_sched_barrier(0);
    LAS float* tot = (LAS float*)(lds + TOT_OFF);
    *(LAS f32x2*)(tot + seg * 64 + 2 * p) = (f32x2){C.cf[0][7], C.cf[1][7]};
    *(LAS f32x2*)(tot + (16 + seg) * 64 + 2 * p) = (f32x2){C.cb[0][0], C.cb[1][0]};
    LBAR();
    float of0 = 0.f, of1 = 0.f, tf0 = 0.f, tf1 = 0.f, ob0 = 0.f, ob1 = 0.f, tb0 = 0.f, tb1 = 0.f;
#pragma unroll
    for (int sg = 0; sg < 16; ++sg) {
        const f32x2 x = *(const LAS f32x2*)(tot + sg * 64 + 2 * p), y = *(const LAS f32x2*)(tot + (16 + sg) * 64 + 2 * p);
        tf0 += x.x; tf1 += x.y; tb0 += y.x; tb1 += y.y;
        if (sg < seg) { of0 += x.x; of1 += x.y; }
        if (sg > seg) { ob0 += y.x; ob1 += y.y; }
    }
#pragma unroll
    for (int s = 0; s < 8; ++s) { C.cf[0][s] += of0; C.cf[1][s] += of1; C.cb[0][s] += ob0; C.cb[1][s] += ob1; }
    C.tf[0] = tf0; C.tf[1] = tf1; C.tb[0] = tb0; C.tb[1] = tb1;
    __builtin_amdgcn_sched_barrier(0);
}
__device__ __forceinline__ void mixer_a_item(const Args& a, int l, int item, LAS unsigned char* lds, int tid, int wave, int lane) {
    asm volatile("" : "+v"(tid)); lane = tid & 63;
    const int h = item & 3, row0 = (item >> 2) * 128;
    const bf16* P = (const bf16*)(a.ws + WS_P);
    const int p = lane & 31, seg = 2 * wave + (lane >> 5);
    LBAR();
    unsigned kraw[8];
    { const bf16* kp = P + (size_t)(row0 + 8 * seg) * NINP + 1280 + h * 64 + 2 * p;
#pragma unroll
    for (int s = 0; s < 8; ++s) kraw[s] = *(const unsigned*)(kp + (size_t)s * NINP); }
    stage_rbuf(P, row0, lds, tid);
    stage_T<false>(P, row0, 1536 + h * 128, lds + MB0, wave, lane, nullptr, nullptr);
    LBAR();
    CumState C; compute_cum(a, l, h, lds, wave, lane, C);
    { f32x4* cq = (f32x4*)(a.ws + WS_CUM) + (size_t)item * 4096 + tid;
      cq[0] = (f32x4){C.cf[0][0], C.cf[0][1], C.cf[0][2], C.cf[0][3]}; cq[512] = (f32x4){C.cf[0][4], C.cf[0][5], C.cf[0][6], C.cf[0][7]};
      cq[1024] = (f32x4){C.cf[1][0], C.cf[1][1], C.cf[1][2], C.cf[1][3]}; cq[1536] = (f32x4){C.cf[1][4], C.cf[1][5], C.cf[1][6], C.cf[1][7]};
      cq[2048] = (f32x4){C.cb[0][0], C.cb[0][1], C.cb[0][2], C.cb[0][3]}; cq[2560] = (f32x4){C.cb[0][4], C.cb[0][5], C.cb[0][6], C.cb[0][7]};
      cq[3072] = (f32x4){C.cb[1][0], C.cb[1][1], C.cb[1][2], C.cb[1][3]}; cq[3584] = (f32x4){C.cb[1][4], C.cb[1][5], C.cb[1][6], C.cb[1][7]}; }
    float k0[8], k1[8];
#pragma unroll
    for (int s = 0; s < 8; ++s) { k0[s] = bf_lo(kraw[s]); k1[s] = bf_hi(kraw[s]); }
    {
        const f32x2 tf2 = (f32x2){C.tf[0], C.tf[1]}, tb2 = (f32x2){C.tb[0], C.tb[1]};
        float ef0[8], ef1[8], eb0[8], eb1[8];
#pragma unroll
        for (int s = 0; s < 8; ++s) {
            const f32x2 k2 = (f32x2){k0[s], k1[s]};
            const f32x2 af = tf2 - (f32x2){C.cf[0][s], C.cf[1][s]}, ab = tb2 - (f32x2){C.cb[0][s], C.cb[1][s]};
            const f32x2 rf = k2 * (f32x2){__builtin_amdgcn_exp2f(af.x), __builtin_amdgcn_exp2f(af.y)}, rb2 = k2 * (f32x2){__builtin_amdgcn_exp2f(ab.x), __builtin_amdgcn_exp2f(ab.y)};
            ef0[s] = rf.x; ef1[s] = rf.y; eb0[s] = rb2.x; eb1[s] = rb2.y;
        }
        *(LAS u32x4*)(lds + MB2 + ((2 * p) * LDT + 8 * seg) * 2) = (u32x4){pk2(ef0[0], ef0[1]), pk2(ef0[2], ef0[3]), pk2(ef0[4], ef0[5]), pk2(ef0[6], ef0[7])};
        *(LAS u32x4*)(lds + MB2 + ((2 * p + 1) * LDT + 8 * seg) * 2) = (u32x4){pk2(ef1[0], ef1[1]), pk2(ef1[2], ef1[3]), pk2(ef1[4], ef1[5]), pk2(ef1[6], ef1[7])};
        *(LAS u32x4*)(lds + MB2 + ((64 + 2 * p) * LDT + 8 * seg) * 2) = (u32x4){pk2(eb0[0], eb0[1]), pk2(eb0[2], eb0[3]), pk2(eb0[4], eb0[5]), pk2(eb0[6], eb0[7])};
        *(LAS u32x4*)(lds + MB2 + ((64 + 2 * p + 1) * LDT + 8 * seg) * 2) = (u32x4){pk2(eb1[0], eb1[1]), pk2(eb1[2], eb1[3]), pk2(eb1[4], eb1[5]), pk2(eb1[6], eb1[7])};
    }
    if (seg == 0) { float* dec = (float*)(a.ws + WS_DEC) + (size_t)item * 128;
        *(f32x2*)(dec + 2 * p) = (f32x2){__builtin_amdgcn_exp2f(C.tf[0]), __builtin_amdgcn_exp2f(C.tf[1])}; *(f32x2*)(dec + 64 + 2 * p) = (f32x2){__builtin_amdgcn_exp2f(C.tb[0]), __builtin_amdgcn_exp2f(C.tb[1])}; }
    LBAR();
    const int dir = wave >> 2, r0 = 32 * (wave & 3), fr = lane & 15, fq = lane >> 4;
    float* DS = (float*)(a.ws + WS_DS) + (size_t)(item * 2 + dir) * 8192 + (r0 + 4 * fq) * 64 + fr;
#pragma unroll
    for (int n = 0; n < 4; ++n) {
        f32x4 acc[2] = {(f32x4){0.f, 0.f, 0.f, 0.f}, (f32x4){0.f, 0.f, 0.f, 0.f}};
        mma_rc<2, 4>((const LAS bf16*)(lds + MB0), LDT, r0, (const LAS bf16*)(lds + MB2) + dir * 64 * LDT, LDT, 16 * n, acc, lane);
#pragma unroll
        for (int t = 0; t < 2; ++t)
#pragma unroll
            for (int r = 0; r < 4; ++r) DS[(16 * t + r) * 64 + 16 * n] = acc[t][r];
    }
}
__device__ __forceinline__ void mixer_scan(const Args& a, int tid) {
    const float* DS = (const float*)(a.ws + WS_DS); const float* DEC = (const float*)(a.ws + WS_DEC); bf16* ST = (bf16*)(a.ws + WS_ST);
    for (int gid = blockIdx.x * NTHR + tid; gid < 16 * 8192; gid += gridDim.x * NTHR) {
        const int elem = gid & 8191, sq = gid >> 13, b = sq >> 3, h = (sq >> 1) & 3, dir = sq & 1;
        const long blk0 = (long)(((b * 64) * 4 + h) * 2 + dir) + (dir ? 63 * 8 : 0); const long bstep = dir ? -8 : 8;
        const float* dsp = DS + blk0 * 8192 + elem; const float* dcp = DEC + blk0 * 64 + (elem & 63); bf16* stp = ST + blk0 * 8192 + elem;
        float ds[64], dc[64];
#pragma unroll
        for (int s = 0; s < 64; ++s) { ds[s] = dsp[(long)s * bstep * 8192]; dc[s] = dcp[(long)s * bstep * 64]; }
        float S = 0.f;
#pragma unroll
        for (int s = 0; s < 64; ++s) { stp[(long)s * bstep * 8192] = (bf16)f2bf(S); S = S * dc[s] + ds[s]; }
    }
}
__device__ __forceinline__ void mixer_c_gla(const Args& a, int l, int item, LAS unsigned char* lds, int tid, int wave, int lane) {
    asm volatile("" : "+v"(tid)); lane = tid & 63;
    const int h = item & 3, row0 = (item >> 2) * 128;
    const bf16* P = (const bf16*)(a.ws + WS_P); bf16* MIX = (bf16*)(a.ws + WS_MIX); const bf16* ST = (const bf16*)(a.ws + WS_ST);
    __syncthreads();
    stage_rbuf(P, row0, lds, tid);
    stage_T<false>(P, row0, 1536 + h * 128, lds + MB0, wave, lane, nullptr, nullptr);
    __syncthreads();
    CumState C; compute_cum(a, l, h, lds, wave, lane, C);
    const int p = lane & 31, seg = 2 * wave + (lane >> 5);
    const bf16* prb = P + (size_t)(row0 + 8 * seg) * NINP + h * 64 + 2 * p;
    LAS unsigned char* qdb = lds + MB2 + (8 * seg * LDT + 2 * p) * 2; LAS unsigned char* kib = lds + MB3 + (8 * seg * LDK + 2 * p) * 2;
#pragma unroll
    for (int s = 0; s < 8; ++s) {
        const bf16* pr = prb + (size_t)s * NINP;
        const unsigned qv = *(const unsigned*)(pr + 1024), kv = *(const unsigned*)(pr + 1280);
        const float q0 = bf_lo(qv), q1 = bf_hi(qv), k0 = bf_lo(kv), k1 = bf_hi(kv);
        *(LAS unsigned*)(qdb + s * LDT * 2) = pk2(q0 * __expf(C.cf[0][s]), q1 * __expf(C.cf[1][s]));
        *(LAS unsigned*)(qdb + s * LDT * 2 + 128) = pk2(q0 * __expf(C.cb[0][s]), q1 * __expf(C.cb[1][s]));
        *(LAS unsigned*)(kib + s * LDK * 2) = pk2(k0 * __expf(-C.cf[0][s]), k1 * __expf(-C.cf[1][s]));
        *(LAS unsigned*)(kib + (128 + s) * LDK * 2) = pk2(k0 * __expf(-C.cb[0][s]), k1 * __expf(-C.cb[1][s]));
        if (s & 1) __builtin_amdgcn_sched_barrier(0);
    }
    __syncthreads();
    const int fr = lane & 15, fq = lane >> 4, w = wave;
#pragma unroll
    for (int t = 0; t < 8; ++t) {
        f32x4 sf[1] = {(f32x4){0.f, 0.f, 0.f, 0.f}}, sb[1] = {(f32x4){0.f, 0.f, 0.f, 0.f}};
        if (t <= w) mma_rc<1, 2>((const LAS bf16*)(lds + MB3), LDK, 16 * t, (const LAS bf16*)(lds + MB2), LDT, 16 * w, sf, lane);
        if (t >= w) mma_rc<1, 2>((const LAS bf16*)(lds + MB3) + 128 * LDK, LDK, 16 * t, (const LAS bf16*)(lds + MB2) + 64, LDT, 16 * w, sb, lane);
        const int i = 16 * w + fr, j0 = 16 * t + 4 * fq;
        float v[4];
#pragma unroll
        for (int r = 0; r < 4; ++r) v[r] = (j0 + r <= i) ? sf[0][r] : sb[0][r];
        *(LAS u32x2*)(lds + MB1 + (i * LDT + 4 * fq) * 2 + 32 * t) = (u32x2){pk2(v[0], v[1]), pk2(v[2], v[3])};
    }
    __syncthreads();
#pragma unroll
    for (int q = 0; q < 4; ++q) { const int c = tid + NTHR * q, dir = c >> 10, cc = c & 1023, e = cc >> 3, part = cc & 7;
        const u32x4 v = *(const u32x4*)(ST + (size_t)(item * 2 + dir) * 8192 + e * 64 + part * 8);
        *(LAS u32x4*)(lds + MB3 + (e * LDT + dir * 64 + part * 8) * 2) = v; }
    f32x4 acc[8];
#pragma unroll
    for (int t = 0; t < 8; ++t) acc[t] = (f32x4){0.f, 0.f, 0.f, 0.f};
    mma_rc<8, 4>((const LAS bf16*)(lds + MB0), LDT, 0, (const LAS bf16*)(lds + MB1), LDT, 16 * w, acc, lane);
    __syncthreads();
    mma_rc<8, 4>((const LAS bf16*)(lds + MB3), LDT, 0, (const LAS bf16*)(lds + MB2), LDT, 16 * w, acc, lane);
    float ss = 0.f;
#pragma unroll
    for (int t = 0; t < 8; ++t) ss += (acc[t][0] * acc[t][0] + acc[t][1] * acc[t][1]) + (acc[t][2] * acc[t][2] + acc[t][3] * acc[t][3]);
    ss += __shfl_xor(ss, 16); ss += __shfl_xor(ss, 32);
    const float rstd = rsqrtf(ss * (1.f / 128.f) + EPS);
    const int row = row0 + 16 * w + fr;
    const bf16* pg = P + (size_t)row * NINP + 2048 + h * 128 + 4 * fq; const float* gg = a.in[11] + (size_t)(l * 4 + h) * 128 + 4 * fq;
    bf16* mo = MIX + (size_t)row * D + 512 + h * 128 + 4 * fq;
#pragma unroll
    for (int t = 0; t < 8; ++t) { const u32x2 gv = *(const u32x2*)(pg + 16 * t); const f32x4 g4 = *(const f32x4*)(gg + 16 * t);
        const float o0 = acc[t][0] * rstd * g4[0] * silu_f(bf_lo(gv.x)), o1 = acc[t][1] * rstd * g4[1] * silu_f(bf_hi(gv.x));
        const float o2 = acc[t][2] * rstd * g4[2] * silu_f(bf_lo(gv.y)), o3 = acc[t][3] * rstd * g4[3] * silu_f(bf_hi(gv.y));
        *(u32x2*)(mo + 16 * t) = (u32x2){pk2(o0, o1), pk2(o2, o3)}; }
}
__device__ __forceinline__ void mixer_c_gmlp(const Args& a, int l, int item, LAS unsigned char* lds, int tid, int wave, int lane) {
    asm volatile("" : "+v"(tid)); lane = tid & 63;
    const int h = item & 3, row0 = (item >> 2) * 128;
    const bf16* P = (const bf16*)(a.ws + WS_P); bf16* MIX = (bf16*)(a.ws + WS_MIX);
    __syncthreads();
    { const float* Ws = a.in[3] + (size_t)(l * 4 + h) * 16384; const int r = tid >> 2, cp = (tid & 3) * 32;
#pragma unroll
      for (int q = 0; q < 4; ++q) { const f32x4 x0 = *(const f32x4*)(Ws + r * 128 + cp + 8 * q), x1 = *(const f32x4*)(Ws + r * 128 + cp + 8 * q + 4);
          *(LAS u32x4*)(lds + MB1 + (r * LDT + cp + 8 * q) * 2) = (u32x4){pk2(x0[0], x0[1]), pk2(x0[2], x0[3]), pk2(x1[0], x1[1]), pk2(x1[2], x1[3])}; } }
    stage_T<true>(P, row0, 512 + h * 128, lds + MB0, wave, lane, a.in[5] + (size_t)(l * 4 + h) * 128, a.in[6] + (size_t)(l * 4 + h) * 128);
    __syncthreads();
    const int fr = lane & 15, fq = lane >> 4, w = wave;
    f32x4 acc[8];
#pragma unroll
    for (int t = 0; t < 8; ++t) acc[t] = (f32x4){0.f, 0.f, 0.f, 0.f};
    mma_rc<8, 4>((const LAS bf16*)(lds + MB0), LDT, 0, (const LAS bf16*)(lds + MB1), LDT, 16 * w, acc, lane);
    const float bsv = a.in[4][(size_t)(l * 4 + h) * 128 + 16 * w + fr];
    const int row = row0 + 16 * w + fr;
    const bf16* up = P + (size_t)row * NINP + h * 128 + 4 * fq; bf16* mo = MIX + (size_t)row * D + h * 128 + 4 * fq;
#pragma unroll
    for (int t = 0; t < 8; ++t) { const u32x2 uv = *(const u32x2*)(up + 16 * t);
        const float o0 = bf_lo(uv.x) * (acc[t][0] + bsv), o1 = bf_hi(uv.x) * (acc[t][1] + bsv), o2 = bf_lo(uv.y) * (acc[t][2] + bsv), o3 = bf_hi(uv.y) * (acc[t][3] + bsv);
        *(u32x2*)(mo + 16 * t) = (u32x2){pk2(o0, o1), pk2(o2, o3)}; }
}
__device__ __forceinline__ void mixer_gla_item(const Args& a, int l, int item, LAS unsigned char* lds, int tid, int wave, int lane, const XcdBarrier& xb, const bool first) {
    asm volatile("" : "+v"(tid)); lane = tid & 63;
    const int h = item & 3, row0 = (item >> 2) * 128;
    const bf16* P = (const bf16*)(a.ws + WS_P); bf16* MIX = (bf16*)(a.ws + WS_MIX); const bf16* ST = (const bf16*)(a.ws + WS_ST);
    const int p = lane & 31, seg = 2 * wave + (lane >> 5), fr = lane & 15, fq = lane >> 4, w = wave;
    const int orow = row0 + 16 * w + fr;
    LBAR();
    unsigned vraw[16];
    { const bf16* src = P + (size_t)(row0 + 16 * wave) * NINP + 1536 + h * 128 + 2 * lane;
#pragma unroll
      for (int s = 0; s < 16; ++s) vraw[s] = *(const unsigned*)(src + (size_t)s * NINP); }
    unsigned qv[8], kv[8];
    { const bf16* prb = P + (size_t)(row0 + 8 * seg) * NINP + h * 64 + 2 * p;
#pragma unroll
      for (int s = 0; s < 8; ++s) { qv[s] = *(const unsigned*)(prb + (size_t)s * NINP + 1024); kv[s] = *(const unsigned*)(prb + (size_t)s * NINP + 1280); } }
    f32x4 cq[8];
    { const f32x4* cp = (const f32x4*)(a.ws + WS_CUM) + (size_t)item * 4096 + tid;
#pragma unroll
      for (int j = 0; j < 8; ++j) cq[j] = cp[512 * j]; }
    u32x2 pgv[8];
    { const bf16* pg = P + (size_t)orow * NINP + 2048 + h * 128 + 4 * fq;
#pragma unroll
      for (int t = 0; t < 8; ++t) pgv[t] = *(const u32x2*)(pg + 16 * t); }
    { LAS u32x4* d0 = (LAS u32x4*)(lds + MB0 + ((2 * lane) * LDT + 16 * wave) * 2); LAS u32x4* d1 = (LAS u32x4*)(lds + MB0 + ((2 * lane + 1) * LDT + 16 * wave) * 2);
#define LO2(x, y) (((x) & 0xffffu) | ((y) << 16))
#define HI2(x, y) (((x) >> 16) | ((y) & 0xffff0000u))
      d0[0] = (u32x4){LO2(vraw[0], vraw[1]), LO2(vraw[2], vraw[3]), LO2(vraw[4], vraw[5]), LO2(vraw[6], vraw[7])};
      d0[1] = (u32x4){LO2(vraw[8], vraw[9]), LO2(vraw[10], vraw[11]), LO2(vraw[12], vraw[13]), LO2(vraw[14], vraw[15])};
      d1[0] = (u32x4){HI2(vraw[0], vraw[1]), HI2(vraw[2], vraw[3]), HI2(vraw[4], vraw[5]), HI2(vraw[6], vraw[7])};
      d1[1] = (u32x4){HI2(vraw[8], vraw[9]), HI2(vraw[10], vraw[11]), HI2(vraw[12], vraw[13]), HI2(vraw[14], vraw[15])}; }
    CumState C;
#pragma unroll
    for (int q = 0; q < 4; ++q) { C.cf[0][q] = cq[0][q]; C.cf[0][4 + q] = cq[1][q]; C.cf[1][q] = cq[2][q]; C.cf[1][4 + q] = cq[3][q]; C.cb[0][q] = cq[4][q]; C.cb[0][4 + q] = cq[5][q]; C.cb[1][q] = cq[6][q]; C.cb[1][4 + q] = cq[7][q]; }
    { LAS unsigned char* qdb = lds + MB2 + (8 * seg * LDT + 2 * p) * 2; LAS unsigned char* kib = lds + MB3 + (8 * seg * LDK + 2 * p) * 2;
#pragma unroll
      for (int s = 0; s < 8; ++s) {
        const f32x2 q2 = (f32x2){bf_lo(qv[s]), bf_hi(qv[s])}, k2 = (f32x2){bf_lo(kv[s]), bf_hi(kv[s])};
        const f32x2 ef = (f32x2){__builtin_amdgcn_exp2f(C.cf[0][s]), __builtin_amdgcn_exp2f(C.cf[1][s])}, eb = (f32x2){__builtin_amdgcn_exp2f(C.cb[0][s]), __builtin_amdgcn_exp2f(C.cb[1][s])};
        const f32x2 nf = (f32x2){__builtin_amdgcn_exp2f(-C.cf[0][s]), __builtin_amdgcn_exp2f(-C.cf[1][s])}, nb = (f32x2){__builtin_amdgcn_exp2f(-C.cb[0][s]), __builtin_amdgcn_exp2f(-C.cb[1][s])};
        const f32x2 qf = q2 * ef, qb = q2 * eb, kf = k2 * nf, kb = k2 * nb;
        *(LAS unsigned*)(qdb + s * LDT * 2) = pk2(qf.x, qf.y);
        *(LAS unsigned*)(qdb + s * LDT * 2 + 128) = pk2(qb.x, qb.y);
        *(LAS unsigned*)(kib + s * LDK * 2) = pk2(kf.x, kf.y);
        *(LAS unsigned*)(kib + (128 + s) * LDK * 2) = pk2(kb.x, kb.y);
        if (s & 1) __builtin_amdgcn_sched_barrier(0);
      } }
    LBAR();
    if (first) xcd_wait(xb, tid);
    u32x4 stv[4];
#pragma unroll
    for (int q = 0; q < 4; ++q) { const int c = tid + NTHR * q, dir = c >> 10, cc = c & 1023; stv[q] = *(const u32x4*)(ST + (size_t)(item * 2 + dir) * 8192 + (cc >> 3) * 64 + (cc & 7) * 8); }
#pragma unroll
    for (int t = 0; t < 8; ++t) {
        f32x4 sf[1] = {(f32x4){0.f, 0.f, 0.f, 0.f}}, sb[1] = {(f32x4){0.f, 0.f, 0.f, 0.f}};
        if (t <= w) mma_rc<1, 2>((const LAS bf16*)(lds + MB3), LDK, 16 * t, (const LAS bf16*)(lds + MB2), LDT, 16 * w, sf, lane);
        if (t >= w) mma_rc<1, 2>((const LAS bf16*)(lds + MB3) + 128 * LDK, LDK, 16 * t, (const LAS bf16*)(lds + MB2) + 64, LDT, 16 * w, sb, lane);
        const int i = 16 * w + fr, j0 = 16 * t + 4 * fq;
        float v[4];
#pragma unroll
        for (int r = 0; r < 4; ++r) v[r] = (j0 + r <= i) ? sf[0][r] : sb[0][r];
        *(LAS u32x2*)(lds + MB1 + (i * LDT + 4 * fq) * 2 + 32 * t) = (u32x2){pk2(v[0], v[1]), pk2(v[2], v[3])};
    }
    LBAR();
#pragma unroll
    for (int q = 0; q < 4; ++q) { const int c = tid + NTHR * q, dir = c >> 10, cc = c & 1023; *(LAS u32x4*)(lds + MB3 + ((cc >> 3) * LDT + dir * 64 + (cc & 7) * 8) * 2) = stv[q]; }
    f32x4 acc[8];
#pragma unroll
    for (int t = 0; t < 8; ++t) acc[t] = (f32x4){0.f, 0.f, 0.f, 0.f};
    mma_rc<8, 4>((const LAS bf16*)(lds + MB0), LDT, 0, (const LAS bf16*)(lds + MB1), LDT, 16 * w, acc, lane);
    LBAR();
    mma_rc<8, 4>((const LAS bf16*)(lds + MB3), LDT, 0, (const LAS bf16*)(lds + MB2), LDT, 16 * w, acc, lane);
    {   float ss = 0.f;
#pragma unroll
        for (int t = 0; t < 8; ++t) ss += (acc[t][0] * acc[t][0] + acc[t][1] * acc[t][1]) + (acc[t][2] * acc[t][2] + acc[t][3] * acc[t][3]);
        ss += __shfl_xor(ss, 16); ss += __shfl_xor(ss, 32);
        const float rstd = rsqrtf(ss * (1.f / 128.f) + EPS);
        const float* gg = a.in[11] + (size_t)(l * 4 + h) * 128 + 4 * fq; bf16* mo = MIX + (size_t)orow * D + 512 + h * 128 + 4 * fq;
        f32x4 g4a[8];
#pragma unroll
        for (int t = 0; t < 8; ++t) g4a[t] = *(const f32x4*)(gg + 16 * t);
#pragma unroll
        for (int t = 0; t < 8; ++t) { const f32x4 g4 = g4a[t];
            const f32x4 ov4 = (acc[t] * rstd) * g4 * silu4((f32x4){bf_lo(pgv[t].x), bf_hi(pgv[t].x), bf_lo(pgv[t].y), bf_hi(pgv[t].y)});
            const float o0 = ov4[0], o1 = ov4[1], o2 = ov4[2], o3 = ov4[3];
            *(u32x2*)(mo + 16 * t) = (u32x2){pk2(o0, o1), pk2(o2, o3)}; } }
}
__device__ __forceinline__ void mixer_gmlp_item(const Args& a, int l, int item, LAS unsigned char* lds, int tid, int wave, int lane) {
    asm volatile("" : "+v"(tid)); lane = tid & 63;
    const int h = item & 3, row0 = (item >> 2) * 128;
    const bf16* P = (const bf16*)(a.ws + WS_P); bf16* MIX = (bf16*)(a.ws + WS_MIX);
    const int fr = lane & 15, fq = lane >> 4, w = wave;
    const int orow = row0 + 16 * w + fr;
    LBAR();
    f32x4 wsv[8];
    { const float* Ws = a.in[3] + (size_t)(l * 4 + h) * 16384 + (tid >> 2) * 128 + (tid & 3) * 32;
#pragma unroll
      for (int q = 0; q < 8; ++q) wsv[q] = *(const f32x4*)(Ws + 4 * q); }
    unsigned araw[16];
    { const bf16* src = P + (size_t)(row0 + 16 * wave) * NINP + 512 + h * 128 + 2 * lane;
#pragma unroll
      for (int s = 0; s < 16; ++s) araw[s] = *(const unsigned*)(src + (size_t)s * NINP); }
    u32x2 uv[8];
    { const bf16* up = P + (size_t)orow * NINP + h * 128 + 4 * fq;
#pragma unroll
      for (int t = 0; t < 8; ++t) uv[t] = *(const u32x2*)(up + 16 * t); }
    { const int r = tid >> 2, cp = (tid & 3) * 32;
#pragma unroll
      for (int q = 0; q < 4; ++q) *(LAS u32x4*)(lds + MB1 + (r * LDT + cp + 8 * q) * 2) = (u32x4){pk2(wsv[2 * q][0], wsv[2 * q][1]), pk2(wsv[2 * q][2], wsv[2 * q][3]), pk2(wsv[2 * q + 1][0], wsv[2 * q + 1][1]), pk2(wsv[2 * q + 1][2], wsv[2 * q + 1][3])}; }
    { float av[16], bv[16];
      const f32x2 g = *(const f32x2*)(a.in[5] + (size_t)(l * 4 + h) * 128 + 2 * lane), bb = *(const f32x2*)(a.in[6] + (size_t)(l * 4 + h) * 128 + 2 * lane);
#pragma unroll
      for (int s = 0; s < 16; ++s) {
          const f32x2 xv = (f32x2){bf_lo(araw[s]), bf_hi(araw[s])};
          const float mu = wave_sum_dpp(xv.x + xv.y) * (1.f / 128.f);
          const f32x2 dv = xv - mu, sq = dv * dv;
          const float rstd = rsqrtf(wave_sum_dpp(sq.x + sq.y) * (1.f / 128.f) + EPS);
          const f32x2 ov2 = __builtin_elementwise_fma(dv * rstd, g, bb);
          av[s] = ov2.x; bv[s] = ov2.y;
      }
      LAS u32x4* d0 = (LAS u32x4*)(lds + MB0 + ((2 * lane) * LDT + 16 * wave) * 2); LAS u32x4* d1 = (LAS u32x4*)(lds + MB0 + ((2 * lane + 1) * LDT + 16 * wave) * 2);
      d0[0] = (u32x4){pk2(av[0], av[1]), pk2(av[2], av[3]), pk2(av[4], av[5]), pk2(av[6], av[7])};
      d0[1] = (u32x4){pk2(av[8], av[9]), pk2(av[10], av[11]), pk2(av[12], av[13]), pk2(av[14], av[15])};
      d1[0] = (u32x4){pk2(bv[0], bv[1]), pk2(bv[2], bv[3]), pk2(bv[4], bv[5]), pk2(bv[6], bv[7])};
      d1[1] = (u32x4){pk2(bv[8], bv[9]), pk2(bv[10], bv[11]), pk2(bv[12], bv[13]), pk2(bv[14], bv[15])}; }
    LBAR();
    f32x4 acc[8];
#pragma unroll
    for (int t = 0; t < 8; ++t) acc[t] = (f32x4){0.f, 0.f, 0.f, 0.f};
    mma_rc<8, 4>((const LAS bf16*)(lds + MB0), LDT, 0, (const LAS bf16*)(lds + MB1), LDT, 16 * w, acc, lane);
    {   const float bsv = a.in[4][(size_t)(l * 4 + h) * 128 + 16 * w + fr];
        bf16* mo = MIX + (size_t)orow * D + h * 128 + 4 * fq;
#pragma unroll
        for (int t = 0; t < 8; ++t) {
            const f32x4 ov4 = (f32x4){bf_lo(uv[t].x), bf_hi(uv[t].x), bf_lo(uv[t].y), bf_hi(uv[t].y)} * (acc[t] + bsv); const float o0 = ov4[0], o1 = ov4[1], o2 = ov4[2], o3 = ov4[3];
            *(u32x2*)(mo + 16 * t) = (u32x2){pk2(o0, o1), pk2(o2, o3)}; } }
}
__device__ __forceinline__ void unpack8(const u32x4 v, float (&f)[8]) { f[0] = bf_lo(v.x); f[1] = bf_hi(v.x); f[2] = bf_lo(v.y); f[3] = bf_hi(v.y); f[4] = bf_lo(v.z); f[5] = bf_hi(v.z); f[6] = bf_lo(v.w); f[7] = bf_hi(v.w); }
__device__ __forceinline__ void conv_act(const Args& a, int l, int tid) {
    const bf16* Y = (const bf16*)(a.ws + WS_R1); bf16* ACT = (bf16*)(a.ws + WS_R2);
    const float* cw = a.in[15] + (size_t)l * 3 * NUP; const float* cb = a.in[16] + (size_t)l * NUP;
    constexpr int NCG = FF / 8, NT = (M / 8) * NCG;
    for (int t = blockIdx.x * NTHR + tid; t < NT; t += gridDim.x * NTHR) {
        const int cgp = t % NCG, rg = t / NCG, j0 = cgp * 8, m0 = rg * 8, pos = m0 & (SEQ - 1);
        float wg[3][8], wv[3][8], bg[8], bv[8];
#pragma unroll
        for (int k = 0; k < 3; ++k)
#pragma unroll
            for (int q = 0; q < 2; ++q) { const f32x4 x = *(const f32x4*)(cw + k * NUP + j0 + 4 * q), y = *(const f32x4*)(cw + k * NUP + FF + j0 + 4 * q);
#pragma unroll
                for (int e = 0; e < 4; ++e) { wg[k][4 * q + e] = x[e]; wv[k][4 * q + e] = y[e]; } }
#pragma unroll
        for (int q = 0; q < 2; ++q) { const f32x4 x = *(const f32x4*)(cb + j0 + 4 * q), y = *(const f32x4*)(cb + FF + j0 + 4 * q);
#pragma unroll
            for (int e = 0; e < 4; ++e) { bg[4 * q + e] = x[e]; bv[4 * q + e] = y[e]; } }
        float pg[8], pv[8], cgv[8], cv[8], ng[8], nv[8];
        const bf16* yr = Y + (size_t)m0 * NUP + j0;
        if (pos > 0) { unpack8(*(const u32x4*)(yr - NUP), pg); unpack8(*(const u32x4*)(yr - NUP + FF), pv); }
        else {
#pragma unroll
            for (int e = 0; e < 8; ++e) { pg[e] = 0.f; pv[e] = 0.f; } }
        unpack8(*(const u32x4*)(yr), cgv); unpack8(*(const u32x4*)(yr + FF), cv);
#pragma unroll
        for (int r = 0; r < 8; ++r) {
            if (r < 7 || pos + 8 < SEQ) { unpack8(*(const u32x4*)(yr + (size_t)(r + 1) * NUP), ng); unpack8(*(const u32x4*)(yr + (size_t)(r + 1) * NUP + FF), nv); }
            else {
#pragma unroll
                for (int e = 0; e < 8; ++e) { ng[e] = 0.f; nv[e] = 0.f; } }
            float o[8];
#pragma unroll
            for (int e = 0; e < 8; ++e) { const float zg = bg[e] + pg[e] * wg[0][e] + cgv[e] * wg[1][e] + ng[e] * wg[2][e];
                const float zv = bv[e] + pv[e] * wv[0][e] + cv[e] * wv[1][e] + nv[e] * wv[2][e]; o[e] = silu_f(zg) * zv; }
            *(u32x4*)(ACT + (size_t)(m0 + r) * FF + j0) = (u32x4){pk2(o[0], o[1]), pk2(o[2], o[3]), pk2(o[4], o[5]), pk2(o[6], o[7])};
#pragma unroll
            for (int e = 0; e < 8; ++e) { pg[e] = cgv[e]; pv[e] = cv[e]; cgv[e] = ng[e]; cv[e] = nv[e]; }
        }
    }
}

__device__ __forceinline__ void conv_fix(const Args& a, int l, int tid) {
    const bf16* YB = (const bf16*)(a.ws + WS_R1); bf16* ACT = (bf16*)(a.ws + WS_R2);
    const float* cw = a.in[15] + (size_t)l * 3 * NUP; const float* cb = a.in[16] + (size_t)l * NUP;
    constexpr int NCG = FF / 8, NT = (M / 64) * 2 * NCG;
    for (int t = blockIdx.x * NTHR + tid; t < NT; t += gridDim.x * NTHR) {
        const int cgp = t % NCG, bw = t / NCG, which = bw & 1, blk = bw >> 1, j0 = cgp * 8;
        const int colg = 256 * (j0 >> 7) + (j0 & 127), row = blk * 64 + (which ? 63 : 0), pos = row & (SEQ - 1);
        float wg[3][8], wv[3][8], bg[8], bv[8];
#pragma unroll
        for (int k = 0; k < 3; ++k)
#pragma unroll
            for (int q = 0; q < 2; ++q) { const f32x4 x = *(const f32x4*)(cw + k * NUP + j0 + 4 * q), y = *(const f32x4*)(cw + k * NUP + FF + j0 + 4 * q);
#pragma unroll
                for (int e = 0; e < 4; ++e) { wg[k][4 * q + e] = x[e]; wv[k][4 * q + e] = y[e]; } }
#pragma unroll
        for (int q = 0; q < 2; ++q) { const f32x4 x = *(const f32x4*)(cb + j0 + 4 * q), y = *(const f32x4*)(cb + FF + j0 + 4 * q);
#pragma unroll
            for (int e = 0; e < 4; ++e) { bg[4 * q + e] = x[e]; bv[4 * q + e] = y[e]; } }
        const bf16* yb = YB + (size_t)(blk * 4) * NUP + colg;
        const bf16* pp = which ? yb + 2 * (size_t)NUP : yb - (size_t)NUP;
        const bf16* cp = which ? yb + 3 * (size_t)NUP : yb;
        const bf16* np = which ? yb + 4 * (size_t)NUP : yb + (size_t)NUP;
        const bool hasp = which || pos > 0, hasn = !which || pos < SEQ - 1;
        float pg[8], pv[8], cgv[8], cv[8], ng[8], nv[8];
        if (hasp) { unpack8(*(const u32x4*)pp, pg); unpack8(*(const u32x4*)(pp + 128), pv); }
        else {
#pragma unroll
            for (int e = 0; e < 8; ++e) { pg[e] = 0.f; pv[e] = 0.f; } }
        unpack8(*(const u32x4*)cp, cgv); unpack8(*(const u32x4*)(cp + 128), cv);
        if (hasn) { unpack8(*(const u32x4*)np, ng); unpack8(*(const u32x4*)(np + 128), nv); }
        else {
#pragma unroll
            for (int e = 0; e < 8; ++e) { ng[e] = 0.f; nv[e] = 0.f; } }
        float o[8];
#pragma unroll
        for (int e = 0; e < 8; ++e) { const float zg = bg[e] + pg[e] * wg[0][e] + cgv[e] * wg[1][e] + ng[e] * wg[2][e];
            const float zv = bv[e] + pv[e] * wv[0][e] + cv[e] * wv[1][e] + nv[e] * wv[2][e]; o[e] = silu_f(zg) * zv; }
        *(u32x4*)(ACT + (size_t)row * FF + j0) = (u32x4){pk2(o[0], o[1]), pk2(o[2], o[3]), pk2(o[4], o[5]), pk2(o[6], o[7])};
    }
}

#ifndef DUP_MASK
#define DUP_MASK 0
#endif
typedef const __attribute__((address_space(4))) Args* KArgsPtr;
__device__ __forceinline__ const Args& kargs() { KArgsPtr p = (KArgsPtr)__builtin_amdgcn_kernarg_segment_ptr(); asm volatile("" : "+s"(p)); return *(const Args*)p; }
__device__ __forceinline__ int lane_id() { return (int)__builtin_amdgcn_mbcnt_hi(~0u, __builtin_amdgcn_mbcnt_lo(~0u, 0u)); }
constexpr int NPH_L = 8;
template <int L, int S>
__device__ __forceinline__ void phase_body(LAS unsigned char* lds, const int wave_s, const XcdBarrier& xb) {
    const Args& a = kargs();
    int lane = lane_id(); asm volatile("" : "+v"(lane));
    const int wave = wave_s, tid = wave * 64 + lane, gw = blockIdx.x * 8 + wave;
    const int G = gridDim.x, NGW = G * 8;
    bf16* XB = (bf16*)(a.ws + WS_XB); bf16* Pb = (bf16*)(a.ws + WS_P); bf16* MIX = (bf16*)(a.ws + WS_MIX); bf16* Yb = (bf16*)(a.ws + WS_R1); bf16* ACT = (bf16*)(a.ws + WS_R2);
    float* SSM = (float*)(a.ws + WS_SSM); float* SSF = (float*)(a.ws + WS_SSF);
    const bf16* Win_t = (const bf16*)(a.ws + WS_WIN); const bf16* Wout_t = (const bf16*)(a.ws + WS_WOUT); const bf16* Wup_t = (const bf16*)(a.ws + WS_WUP); const bf16* Wdn_t = (const bf16*)(a.ws + WS_WDOWN);
    if constexpr (L < 0) {
        convert_weights(a, 0, 5, lds, gw, NGW, wave, lane);
        prologue_rows(a.in[0], a.in[1], XB, SSM, gw, NGW, lane);
    } else if constexpr (S == 0) {
        pg8::Gemm g{XB, Win_t, M, NINP, D}; PrefetchOrder So; So.init(M, NINP, G, (int)blockIdx.x); So.ssp = SSM; So.cw = nullptr; So.cb = nullptr; So.xl = lds + XL_OFF; So.tid = tid; So.cnt = 0; EpiIn E{Pb, lds + XL_OFF, 0};
        pg8::gemm_phase<EpiIn, PrefetchOrder, PG8_ALIGN, PG8_SP2>(lds, g, So, E, tid);
    } else if constexpr (S == 1) {
        for (int item = blockIdx.x; item < 512; item += G) mixer_a_item(a, L, item, lds, tid, wave, lane);
        xcd_arrive(xb, tid);
        for (int item = blockIdx.x; item < 512; item += G) mixer_gmlp_item(a, L, item, lds, tid, wave, lane);
        xcd_wait(xb, tid);
    } else if constexpr (S == 2) {
        mixer_scan(a, tid);
        xcd_arrive(xb, tid);
    } else if constexpr (S == 3) {
        for (int item = blockIdx.x; item < 512; item += G) mixer_gla_item(a, L, item, lds, tid, wave, lane, xb, item == (int)blockIdx.x);
        xcd_arrive(xb, tid);
        convert_weights(a, L, 2, lds, gw, NGW, wave, lane);
        xcd_wait(xb, tid);
    } else if constexpr (S == 4) {
        pg8::Gemm g{MIX, Wout_t, M, D, D}; pg8::StaticOrder So; So.init(M, D, G, (int)blockIdx.x); EpiRes16<false> E{XB, nullptr, SSF, nullptr, nullptr};
        pg8::gemm_phase<EpiRes16<false>, pg8::StaticOrder, false, PG8_SP2>(lds, g, So, E, tid);
    } else if constexpr (S == 5) {
        pg8::Gemm g{XB, Wup_t, M, NUP, D}; PrefetchOrder So; So.init(M, NUP, G, (int)blockIdx.x); So.ssp = SSF; So.cw = a.in[15] + (size_t)L * 3 * NUP; So.cb = a.in[16] + (size_t)L * NUP; So.xl = lds + XL_OFF; So.tid = tid; So.cnt = 0; EpiUpConv E{ACT, Yb, lds + XL_OFF, 0};
        pg8::gemm_phase<EpiUpConv, PrefetchOrder, PG8_ALIGN, PG8_SP2>(lds, g, So, E, tid);
        { constexpr int NU = (M / 256) * (NUP / 256); const int nfull = NU % G;
          if (L + 1 < DEPTH && (int)blockIdx.x >= nfull) convert_weights(a, L + 1, 1, lds, ((int)blockIdx.x - nfull) * 8 + wave, (G - nfull) * 8, wave, lane); }
        xcd_barrier(xb, tid);
    } else if constexpr (S == 6) {
        conv_fix(a, L, tid);
        if (L + 1 < DEPTH) { xcd_arrive(xb, tid); convert_weights(a, L + 1, 4, lds, gw, NGW, wave, lane); xcd_wait(xb, tid); }
        else xcd_barrier(xb, tid);
    } else if constexpr (S == 7) {
        pg8::Gemm g{ACT, Wdn_t, M, D, FF}; pg8::StaticOrder So; So.init(M, D, G, (int)blockIdx.x); EpiRes16<(L + 1 == DEPTH)> E{XB, a.out, SSM, a.in[18], (unsigned*)a.ws + CW_PCNT};
        pg8::gemm_phase<EpiRes16<(L + 1 == DEPTH)>, pg8::StaticOrder, false, PG8_SP2>(lds, g, So, E, tid);
    } else {
        final_rows(a.out, a.in[18], SSM, gw, NGW, lane);
    }
}
#define SEAM() do { const int t_ = wave_s * 64 + lane_id(); xcd_barrier(xb, t_); } while (0)
#define RUN(L, S) { constexpr int k_ = 1 + NPH_L * (L) + (S); if (ph_lo <= k_ && k_ < ph_hi) { phase_body<L, S>(lds, wave_s, xb); \
    if constexpr ((S) == 0 || (S) == 4 || (S) == 7) { if (k_ + 1 < ph_hi) SEAM(); } } }
#define RUN_LAYER(L) RUN(L, 0) RUN(L, 1) RUN(L, 2) RUN(L, 3) RUN(L, 4) RUN(L, 5) RUN(L, 6) RUN(L, 7)
__global__ void __launch_bounds__(NTHR, 2) mk_fwd(Args a) {
    extern __shared__ __attribute__((aligned(16))) unsigned char lds_raw[];
    LAS unsigned char* lds = (LAS unsigned char*)lds_raw;
    cg::grid_group grid = cg::this_grid();
    const int wave_s = __builtin_amdgcn_readfirstlane((int)(threadIdx.x >> 6));
    volatile LAS unsigned* MISC = (volatile LAS unsigned*)(lds + MISC_OFF);
    if (threadIdx.x < 4) MISC[threadIdx.x] = 0u;
    __syncthreads();
    const int ph_lo = kargs().ph_lo, ph_hi = kargs().ph_hi;
    XcdBarrier xb = xcd_barrier_post((unsigned*)kargs().ws + CW_BAR, MISC, (int)threadIdx.x);
    if (ph_lo <= 0 && 0 < ph_hi) {
        phase_body<-1, 0>(lds, wave_s, xb);
        if (ph_lo < -1) grid.sync();
        if (1 < ph_hi) SEAM();
    }
    RUN_LAYER(0)
    RUN_LAYER(1)
    RUN_LAYER(2)
    RUN_LAYER(3)
}

extern "C" void kernel_launch(void* const* d_in, const int* in_sizes, int n_in, void* d_out, int out_size, void* d_ws, size_t ws_size, hipStream_t stream) {
    static int grid = 0;
    if (grid == 0) {
        if (n_in != 19 || out_size != M * D || ws_size < WS_END) { fprintf(stderr, "kernel_launch: unexpected shapes / workspace (%d inputs, out %d, ws %zu)\n", n_in, out_size, ws_size); grid = -1; return; }
        int dev = 0, cus = 0, per_cu = 0;
        hipGetDevice(&dev); hipDeviceGetAttribute(&cus, hipDeviceAttributeMultiprocessorCount, dev);
        hipFuncSetAttribute((const void*)mk_fwd, hipFuncAttributeMaxDynamicSharedMemorySize, LDS_BYTES);
        hipOccupancyMaxActiveBlocksPerMultiprocessor(&per_cu, (const void*)mk_fwd, NTHR, LDS_BYTES);
        if (per_cu < 1) per_cu = 1;
        grid = cus * per_cu;
        if (grid != 256) { fprintf(stderr, "kernel_launch: built for a 256-workgroup grid (one per CU), got %d\n", grid); grid = -1; return; }
        (void)hipGetLastError();
    }
    if (grid < 0) return;
    if (hipMemsetAsync(d_ws, 0, CTL_ZERO_BYTES, stream) != hipSuccess) return;
    Args a{};
    for (int i = 0; i < 19; ++i) a.in[i] = (const float*)d_in[i];
    a.out = (float*)d_out; a.ws = (unsigned char*)d_ws;
#if MK_SINGLE
    a.ph_lo = 0; a.ph_hi = NPHASE;
    void* args[] = {&a};
    hipError_t e = hipLaunchCooperativeKernel((const void*)mk_fwd, dim3(grid), dim3(NTHR), args, LDS_BYTES, stream);
    if (e != hipSuccess) fprintf(stderr, "cooperative launch failed: %s (grid %d)\n", hipGetErrorString(e), grid);
#else
    for (int ph = 0; ph < NPHASE; ++ph) { a.ph_lo = ph; a.ph_hi = ph + 1; hipLaunchKernelGGL(mk_fwd, dim3(grid), dim3(NTHR), LDS_BYTES, stream, a); }
#endif
}
```
